# Optimizing an MI355X kernel written in HIP

```python
import math
import jax, jax.numpy as jnp
from jax import lax
import numpy as np


D_MODEL = 1024
BATCH = 16
SEQ = 2048
DEPTH = 4
DEC_BATCH = 32
DEC_SEQ = 2048
PAST_LEN = 128

HEAD_DIM = 64
N_HEADS_A = 8
N_KV_A = 2
N_HEADS_B = 8
N_KV_B = 2
WIDTH_A = N_HEADS_A * HEAD_DIM
WIDTH_B = N_HEADS_B * HEAD_DIM
KVW_A = N_KV_A * HEAD_DIM
KVW_B = N_KV_B * HEAD_DIM
MIX_WIDTH = WIDTH_A + WIDTH_B
IN_WIDTH = WIDTH_A + 2 * KVW_A + WIDTH_B + 2 * KVW_B
Q_BLOCK = 128
BAND_BLOCK = 128
WINDOW = 128
ROPE_THETA = 10000.0
GRID_W = 64
D_FF = 2816
CONV_W = 3
D_PLE = 256
NORM_EPS = 1e-5
QK_EPS = 1e-6
ALPHA = (2 * DEPTH) ** 0.25
BETA = (8 * DEPTH) ** -0.25

kernel_name = 'hymba_axial_window_sink_encoder'

F32 = jnp.float32


def layer_norm(x, g, b):
    xf = x.astype(F32)
    mu = jnp.mean(xf, -1, keepdims=True)
    var = jnp.mean(jnp.square(xf - mu), -1, keepdims=True)
    return ((xf - mu) * lax.rsqrt(var + NORM_EPS) * g.astype(F32) + b.astype(F32)).astype(x.dtype)


def rms_norm(x, g, eps):
    xf = x.astype(F32)
    return xf * lax.rsqrt(jnp.mean(xf * xf, -1, keepdims=True) + eps) * g.astype(F32)


def rope_angles_1d(n):
    pos = jnp.arange(n, dtype=F32)
    inv = ROPE_THETA ** (-jnp.arange(0, HEAD_DIM, 2, dtype=F32) / HEAD_DIM)
    return pos[:, None] * inv[None, :]


def rope_angles_2d(n):
    rows = n // GRID_W
    row = jnp.repeat(jnp.arange(rows, dtype=F32), GRID_W)
    col = jnp.tile(jnp.arange(GRID_W, dtype=F32), rows)
    axis_dim = HEAD_DIM // 2
    inv = ROPE_THETA ** (-jnp.arange(0, axis_dim, 2, dtype=F32) / axis_dim)
    return jnp.concatenate([row[:, None] * inv[None, :], col[:, None] * inv[None, :]], -1)


def apply_rope(x, ang):
    xf = x.astype(F32).reshape(x.shape[:-1] + (HEAD_DIM // 2, 2))
    c = jnp.cos(ang)[None, :, None, :]
    s = jnp.sin(ang)[None, :, None, :]
    x0, x1 = xf[..., 0], xf[..., 1]
    return jnp.stack([x0 * c - x1 * s, x0 * s + x1 * c], -1).reshape(x.shape)


def global_axial_attention(q, k, v, q_gain, k_gain, ang2d):
    B, S = q.shape[0], q.shape[1]
    G = N_HEADS_A // N_KV_A
    q = apply_rope(rms_norm(q, q_gain, QK_EPS), ang2d) * (HEAD_DIM ** -0.5)
    k = apply_rope(rms_norm(k, k_gain, QK_EPS), ang2d)
    v = v.astype(F32)
    nq = S // Q_BLOCK
    qb = q.reshape(B, nq, Q_BLOCK, N_KV_A, G, HEAD_DIM).transpose(1, 0, 2, 3, 4, 5)

    def attend(qblk):
        s = jnp.einsum('bqkgd,bskd->bkgqs', qblk, k)
        p = jax.nn.softmax(s, axis=-1)
        return jnp.einsum('bkgqs,bskd->bqkgd', p, v)

    o = lax.map(attend, qb)
    return o.transpose(1, 0, 2, 3, 4, 5).reshape(B, S, WIDTH_A)


def window_sink_attention(q, k, v, sink, ang1d):
    B, S = q.shape[0], q.shape[1]
    G = N_HEADS_B // N_KV_B
    BB = BAND_BLOCK
    nb = S // BB
    q = apply_rope(q, ang1d) * (HEAD_DIM ** -0.5)
    k = apply_rope(k, ang1d)
    v = v.astype(F32)
    pad = ((0, 0), (BB, BB), (0, 0), (0, 0))
    kp = jnp.pad(k, pad).reshape(B, nb + 2, BB, N_KV_B, HEAD_DIM)
    vp = jnp.pad(v, pad).reshape(B, nb + 2, BB, N_KV_B, HEAD_DIM)
    kband = jnp.concatenate([kp[:, :-2], kp[:, 1:-1], kp[:, 2:]], axis=2)
    vband = jnp.concatenate([vp[:, :-2], vp[:, 1:-1], vp[:, 2:]], axis=2)
    qb = q.reshape(B, nb, BB, N_KV_B, G, HEAD_DIM)
    a = jnp.arange(BB)[:, None]
    j = jnp.arange(3 * BB)[None, :]
    band = jnp.abs(j - BB - a) <= WINDOW
    sink_l = sink.astype(F32).reshape(1, N_KV_B, G, 1, 1)

    def attend(args):
        blk, qblk, kblk, vblk = args
        kpos = blk * BB - BB + jnp.arange(3 * BB)
        mask = band & ((kpos >= 0) & (kpos < S))[None, :]
        s = jnp.einsum('bqkgd,bskd->bkgqs', qblk, kblk)
        s = jnp.where(mask, s, -jnp.inf)
        m = jnp.maximum(jnp.max(s, -1, keepdims=True), sink_l)
        e = jnp.exp(s - m)
        denom = jnp.sum(e, -1, keepdims=True) + jnp.exp(sink_l - m)
        return jnp.einsum('bkgqs,bskd->bqkgd', e / denom, vblk)

    o = lax.map(attend, (jnp.arange(nb), qb.transpose(1, 0, 2, 3, 4, 5),
                         kband.transpose(1, 0, 2, 3, 4), vband.transpose(1, 0, 2, 3, 4)))
    return o.transpose(1, 0, 2, 3, 4, 5).reshape(B, S, WIDTH_B)


def hybrid_mixer(x, w_in, q_gain, k_gain, sink, out_gain_a, out_gain_b, w_out, ang1d, ang2d):
    B, S = x.shape[0], x.shape[1]
    h = x @ w_in
    o1 = WIDTH_A
    o2 = o1 + KVW_A
    o3 = o2 + KVW_A
    o4 = o3 + WIDTH_B
    o5 = o4 + KVW_B
    qa, ka, va, qb, kb, vb = jnp.split(h, [o1, o2, o3, o4, o5], axis=-1)
    oa = global_axial_attention(qa.reshape(B, S, N_HEADS_A, HEAD_DIM), ka.reshape(B, S, N_KV_A, HEAD_DIM),
                                va.reshape(B, S, N_KV_A, HEAD_DIM), q_gain, k_gain, ang2d)
    ob = window_sink_attention(qb.reshape(B, S, N_HEADS_B, HEAD_DIM), kb.reshape(B, S, N_KV_B, HEAD_DIM),
                               vb.reshape(B, S, N_KV_B, HEAD_DIM), sink, ang1d)
    o = jnp.concatenate([rms_norm(oa, out_gain_a, NORM_EPS), rms_norm(ob, out_gain_b, NORM_EPS)], -1)
    return o.astype(x.dtype) @ w_out


def conv_glu(x, w_up, conv_w, conv_b, w_down):
    S = x.shape[1]
    g, v = jnp.split(x @ w_up, 2, axis=-1)
    gp = jnp.pad(g, ((0, 0), (1, 1), (0, 0)))
    g = gp[:, :S] * conv_w[0] + gp[:, 1:S + 1] * conv_w[1] + gp[:, 2:S + 2] * conv_w[2] + conv_b
    return (jax.nn.gelu(g) * v) @ w_down


def encoder_trunk(x, p, ln0_g, ln0_b, w_in, q_norm, k_norm, sink, out_norm_a, out_norm_b, w_out,
                  ln1_g, ln1_b, w_up, conv_w, conv_b, w_down, ln2_g, ln2_b, w_ple, w_ple_gate, b_ple_gate):
    S = x.shape[1]
    ang1d = rope_angles_1d(S)
    ang2d = rope_angles_2d(S)
    x = layer_norm(x, ln0_g, ln0_b)
    for i in range(DEPTH):
        mix = hybrid_mixer(x, w_in[i], q_norm[i], k_norm[i], sink[i], out_norm_a[i], out_norm_b[i],
                           w_out[i], ang1d, ang2d)
        x = layer_norm(ALPHA * x + mix, ln1_g[i], ln1_b[i])
        ffn = conv_glu(x, w_up[i], conv_w[i], conv_b[i], w_down[i])
        gate = jax.nn.sigmoid(x @ w_ple_gate[i] + b_ple_gate[i])
        ple = p[i].astype(x.dtype) @ w_ple[i]
        x = layer_norm(ALPHA * x + ffn + gate * ple, ln2_g[i], ln2_b[i])
    return x


def setup_inputs(seed: int = 0) -> dict:
    key = jax.random.key(seed)
    ks = jax.random.split(key, 24)
    nrm = lambda k, shp, s: jax.random.normal(k, shp, F32) * s
    return {
        'x_prompt': nrm(ks[0], (BATCH, SEQ, D_MODEL), 1.0),
        'x_sample': nrm(ks[1], (DEC_BATCH, DEC_SEQ, D_MODEL), 1.0),
        'p_prompt': nrm(ks[2], (DEPTH, BATCH, SEQ, D_PLE), 1.0),
        'p_sample': nrm(ks[3], (DEPTH, DEC_BATCH, DEC_SEQ, D_PLE), 1.0),
        'ln0_g': 1.0 + nrm(ks[4], (D_MODEL,), 0.02),
        'ln0_b': nrm(ks[5], (D_MODEL,), 0.02),
        'w_in': nrm(ks[6], (DEPTH, D_MODEL, IN_WIDTH), D_MODEL ** -0.5),
        'q_norm': 1.0 + nrm(ks[7], (DEPTH, HEAD_DIM), 0.02),
        'k_norm': 1.0 + nrm(ks[8], (DEPTH, HEAD_DIM), 0.02),
        'sink': nrm(ks[9], (DEPTH, N_HEADS_B), 1.0),
        'out_norm_a': 1.0 + nrm(ks[10], (DEPTH, WIDTH_A), 0.02),
        'out_norm_b': 1.0 + nrm(ks[11], (DEPTH, WIDTH_B), 0.02),
        'w_out': nrm(ks[12], (DEPTH, MIX_WIDTH, D_MODEL), BETA * MIX_WIDTH ** -0.5),
        'ln1_g': 1.0 + nrm(ks[13], (DEPTH, D_MODEL), 0.02),
        'ln1_b': nrm(ks[14], (DEPTH, D_MODEL), 0.02),
        'w_up': nrm(ks[15], (DEPTH, D_MODEL, 2 * D_FF), D_MODEL ** -0.5),
        'conv_w': nrm(ks[16], (DEPTH, CONV_W, D_FF), CONV_W ** -0.5),
        'conv_b': nrm(ks[17], (DEPTH, D_FF), 0.01),
        'w_down': nrm(ks[18], (DEPTH, D_FF, D_MODEL), BETA * D_FF ** -0.5),
        'ln2_g': 1.0 + nrm(ks[19], (DEPTH, D_MODEL), 0.02),
        'ln2_b': nrm(ks[20], (DEPTH, D_MODEL), 0.02),
        'w_ple': nrm(ks[21], (DEPTH, D_PLE, D_MODEL), BETA * D_PLE ** -0.5),
        'w_ple_gate': nrm(ks[22], (DEPTH, D_MODEL, D_MODEL), D_MODEL ** -0.5),
        'b_ple_gate': nrm(ks[23], (DEPTH, D_MODEL), 0.01),
    }


def reference(x_prompt, x_sample, p_prompt, p_sample, ln0_g, ln0_b, w_in, q_norm, k_norm, sink,
              out_norm_a, out_norm_b, w_out, ln1_g, ln1_b, w_up, conv_w, conv_b, w_down,
              ln2_g, ln2_b, w_ple, w_ple_gate, b_ple_gate):
    y_prompt = encoder_trunk(x_prompt, p_prompt, ln0_g, ln0_b, w_in, q_norm, k_norm, sink, out_norm_a,
                             out_norm_b, w_out, ln1_g, ln1_b, w_up, conv_w, conv_b, w_down, ln2_g, ln2_b,
                             w_ple, w_ple_gate, b_ple_gate)
    y_sample = encoder_trunk(x_sample, p_sample, ln0_g, ln0_b, w_in, q_norm, k_norm, sink, out_norm_a,
                             out_norm_b, w_out, ln1_g, ln1_b, w_up, conv_w, conv_b, w_down, ln2_g, ln2_b,
                             w_ple, w_ple_gate, b_ple_gate)
    return (y_prompt, y_sample)
```

```cpp
#include <hip/hip_runtime.h>
#include <hip/hip_cooperative_groups.h>
#include <cstdio>
#include <cstdint>
namespace cg = cooperative_groups;
namespace pg8 {
#define PG8_LAS __attribute__((address_space(3)))
typedef unsigned short bf16_t;
typedef short bf16x8 __attribute__((ext_vector_type(8)));
typedef float f32x4 __attribute__((ext_vector_type(4)));
typedef unsigned u32x4 __attribute__((ext_vector_type(4)));
constexpr int BM = 256, BK = 64, HALF = 128, HTB = HALF * BK * 2  , STAGE_BYTES = 8 * HTB, NXCD = 8, WGM = 8;

__host__ __device__ __forceinline__ int lds_byte(int r, int c) { const int st = (r >> 4) * 2 + (c >> 5), rr = r & 15, cc = c & 31, ob = rr * 64 + cc * 2; return st * 1024 + (ob ^ (((ob >> 9) & 1) << 5)); }
__host__ __device__ __forceinline__ void stage_rc(int b, int& R, int& C) { const int st = b / 1024, sb = b % 1024, swz = sb ^ (((sb >> 9) & 1) << 5); R = (st >> 1) * 16 + swz / 64; C = (st & 1) * 32 + (swz % 64) / 2; }
__host__ __device__ __forceinline__ int perm32(int rho) { const int n = rho >> 4, i = rho & 15; return 8 * (i >> 2) + 4 * n + (i & 3); }

struct Unit { int pm, pn; };
struct Gemm { const bf16_t* A; const bf16_t* Bt; int M, N, K; };

struct StaticOrder {
    int nM, nN, nwg, G, c;
    __host__ __device__ void init(int M, int N, int G_, int c_) { nM = M / BM; nN = N / BM; nwg = nM * nN; G = G_; c = c_; }
    __host__ __device__ bool next(int i, Unit& u) const {
        const long L = (long)i * G + c; if (L >= nwg) return false;
        int wgid = (int)L; { const int q = nwg / NXCD, r = nwg % NXCD, xcd = wgid % NXCD, off = wgid / NXCD; wgid = (xcd < r ? xcd * (q + 1) : r * (q + 1) + (xcd - r) * q) + off; }
        const int nig = WGM * nN, gid = wgid / nig, fm = gid * WGM, gsz = (nM - fm) < WGM ? (nM - fm) : WGM;
        u.pm = fm + ((wgid % nig) % gsz); u.pn = (wgid % nig) / gsz; return true;
    }
    __device__ __forceinline__ void a_ready(const Unit&) const {}
    __device__ __forceinline__ void done(const Unit&) const {}
};

__device__ __forceinline__ unsigned cvt_pk_bf16(float lo, float hi) { unsigned r; asm volatile("v_cvt_pk_bf16_f32 %0, %1, %2" : "=v"(r) : "v"(lo), "v"(hi)); return r; }
template <class Epi, class Sched, bool ALIGN_EPI = false, bool SP2 = false>
__device__ __forceinline__ void gemm_phase(PG8_LAS unsigned char* lds, const Gemm g, const Sched& S, const Epi& E) {
    int tid_ = threadIdx.x; asm volatile("" : "+v"(tid_));
    const int tid = tid_, wid = __builtin_amdgcn_readfirstlane(tid >> 6), lane = tid & 63, wr = wid >> 2, wc = wid & 3, fr = lane & 15, fq = lane >> 4;
    const int K = g.K, nt = K / BK;
    unsigned voffA[2], voffB[2];
#pragma unroll
    for (int i = 0; i < 2; ++i) { int R, C; stage_rc(tid * 16 + i * 8192, R, C); const int Rb = Epi::PERM ? ((R & ~31) + perm32(R & 31)) : R;
        voffA[i] = (unsigned)(R * K + C) * 2u; voffB[i] = (unsigned)(Rb * K + C) * 2u; }
    const size_t kstep = (size_t)(BK * 2);
    const size_t hstep = (size_t)HALF * K * 2;
    const size_t tstep = 2 * hstep;
    const unsigned ldsw = (unsigned)wid * 1024u;
    const int aoff = lds_byte(wr * 64 + fr, fq * 8), boff = lds_byte(wc * 32 + fr, fq * 8);
#define PG8_SA(b, h) (((b) * 2 + (h)) * HTB)
#define PG8_SB(b, h) ((4 + (b) * 2 + (h)) * HTB)
#define PG8_STAGE(bufoff, gbase, voff) do { _Pragma("unroll") for (int _i = 0; _i < 2; ++_i) \
        __builtin_amdgcn_global_load_lds((const unsigned*)((const char*)(gbase) + (voff)[_i]), (PG8_LAS unsigned*)(lds + (bufoff) + ldsw + _i * 8192), 16, 0, 0); } while (0)
#define PG8_LDA(dst, b, h) do { _Pragma("unroll") for (int m = 0; m < 4; ++m) _Pragma("unroll") for (int k = 0; k < 2; ++k) dst[m][k] = *(const PG8_LAS bf16x8*)(lds + PG8_SA(b, h) + aoff + m * 2048 + k * 1024); } while (0)
#define PG8_LDB(dst, b, h) do { _Pragma("unroll") for (int n = 0; n < 2; ++n) _Pragma("unroll") for (int k = 0; k < 2; ++k) dst[n][k] = *(const PG8_LAS bf16x8*)(lds + PG8_SB(b, h) + boff + n * 2048 + k * 1024); } while (0)
#define PG8_MMA(ai, bj, At, Bt) do { __builtin_amdgcn_s_setprio(1); _Pragma("unroll") for (int m = 0; m < 4; ++m) _Pragma("unroll") for (int n = 0; n < 2; ++n) _Pragma("unroll") for (int k = 0; k < 2; ++k) \
        acc[ai][bj][m][n] = __builtin_amdgcn_mfma_f32_16x16x32_bf16(Bt[n][k], At[m][k], acc[ai][bj][m][n], 0, 0, 0); __builtin_amdgcn_s_setprio(0); } while (0)
#define PG8_WAIT_V(n) asm volatile("s_waitcnt vmcnt(" #n ")" ::: "memory")
#define PG8_WAIT_L(n) asm volatile("s_waitcnt lgkmcnt(" #n ")" ::: "memory")
#define PG8_BAR __builtin_amdgcn_s_barrier()
#define PG8_SCHED __builtin_amdgcn_sched_barrier(0)
    Unit cur, nxt; int ui = 0;
    if (!S.next(0, cur)) return;
    f32x4 acc[2][2][4][2];
#pragma unroll
    for (int a = 0; a < 2; ++a)
#pragma unroll
        for (int b = 0; b < 2; ++b)
#pragma unroll
            for (int m = 0; m < 4; ++m)
#pragma unroll
                for (int n = 0; n < 2; ++n) acc[a][b][m][n] = (f32x4){0.f, 0.f, 0.f, 0.f};
    bf16x8 At[4][2], B0[2][2], B1[2][2];
    const char* cA = (const char*)g.A + (size_t)cur.pm * tstep; const char* cB = (const char*)g.Bt + (size_t)cur.pn * tstep;
    S.a_ready(cur);
    if constexpr (SP2) {
        PG8_STAGE(PG8_SB(0, 0), cB, voffB); PG8_STAGE(PG8_SB(0, 1), cB + hstep, voffB); PG8_STAGE(PG8_SA(0, 0), cA, voffA); PG8_STAGE(PG8_SA(0, 1), cA + hstep, voffA);
        if (wr == 1) PG8_BAR;
        PG8_WAIT_V(2); PG8_BAR;
        PG8_STAGE(PG8_SB(1, 0), cB + kstep, voffB); PG8_STAGE(PG8_SA(1, 0), cA + kstep, voffA); PG8_STAGE(PG8_SB(1, 1), cB + hstep + kstep, voffB);
        PG8_WAIT_V(6); PG8_BAR;
    } else {
        PG8_STAGE(PG8_SB(0, 0), cB, voffB); PG8_STAGE(PG8_SA(0, 0), cA, voffA); PG8_STAGE(PG8_SB(0, 1), cB + hstep, voffB); PG8_STAGE(PG8_SA(0, 1), cA + hstep, voffA);
        if (wr == 1) PG8_BAR;
        PG8_WAIT_V(4); PG8_BAR;
        PG8_STAGE(PG8_SB(1, 0), cB + kstep, voffB); PG8_STAGE(PG8_SA(1, 0), cA + kstep, voffA); PG8_STAGE(PG8_SB(1, 1), cB + hstep + kstep, voffB);
        PG8_WAIT_V(6); PG8_BAR;
    }
    for (;;) {
        const bool has_next = S.next(ui + 1, nxt);
        const char* nA = has_next ? (const char*)g.A + (size_t)nxt.pm * tstep : cA; const char* nB = has_next ? (const char*)g.Bt + (size_t)nxt.pn * tstep : cB;
        for (int t = 0; t < nt; t += 2) {
            const bool last = (t == nt - 2);
            const char* a1 = cA + (size_t)(t + 1) * kstep;
            const char* a2 = last ? nA : cA + (size_t)(t + 2) * kstep; const char* b2 = last ? nB : cB + (size_t)(t + 2) * kstep;
            const char* a3 = a2 + kstep; const char* b3 = b2 + kstep;
            if (last && has_next) S.a_ready(nxt);
            if constexpr (SP2) {
            PG8_LDB(B0, 0, 0); PG8_LDB(B1, 0, 1); PG8_SCHED; PG8_LDA(At, 0, 0); PG8_STAGE(PG8_SA(1, 1), a1 + hstep, voffA);
            PG8_WAIT_V(8); PG8_WAIT_L(0); PG8_BAR; PG8_MMA(0, 0, At, B0); PG8_MMA(0, 1, At, B1); PG8_BAR; PG8_SCHED;
            PG8_LDA(At, 0, 1); PG8_STAGE(PG8_SB(0, 0), b2, voffB); PG8_STAGE(PG8_SB(0, 1), b2 + hstep, voffB); PG8_STAGE(PG8_SA(0, 0), a2, voffA);
            PG8_WAIT_V(8); PG8_WAIT_L(0); PG8_BAR; PG8_MMA(1, 0, At, B0); PG8_MMA(1, 1, At, B1); PG8_BAR; PG8_SCHED;
            PG8_LDB(B0, 1, 0); PG8_LDB(B1, 1, 1); PG8_SCHED; PG8_LDA(At, 1, 0); PG8_STAGE(PG8_SA(0, 1), a2 + hstep, voffA);
            PG8_WAIT_V(8); PG8_WAIT_L(0); PG8_BAR; PG8_MMA(0, 0, At, B0); PG8_MMA(0, 1, At, B1); PG8_BAR; PG8_SCHED;
            PG8_LDA(At, 1, 1); PG8_STAGE(PG8_SB(1, 0), b3, voffB); PG8_STAGE(PG8_SB(1, 1), b3 + hstep, voffB); PG8_STAGE(PG8_SA(1, 0), a3, voffA);
            PG8_WAIT_V(8); PG8_WAIT_L(0); PG8_BAR; PG8_MMA(1, 0, At, B0); PG8_MMA(1, 1, At, B1); PG8_BAR; PG8_SCHED;
            } else {
            PG8_LDB(B0, 0, 0); PG8_SCHED; PG8_LDA(At, 0, 0); PG8_STAGE(PG8_SA(1, 1), a1 + hstep, voffA);
            PG8_WAIT_L(8); PG8_BAR; PG8_WAIT_L(0); PG8_MMA(0, 0, At, B0); PG8_BAR; PG8_SCHED;
            PG8_LDB(B1, 0, 1); PG8_STAGE(PG8_SB(0, 0), b2, voffB);
            PG8_BAR; PG8_WAIT_L(0); PG8_MMA(0, 1, At, B1); PG8_BAR;
            PG8_LDA(At, 0, 1); PG8_STAGE(PG8_SA(0, 0), a2, voffA);
            PG8_BAR; PG8_WAIT_L(0); PG8_MMA(1, 0, At, B0); PG8_BAR; PG8_SCHED;
            PG8_STAGE(PG8_SB(0, 1), b2 + hstep, voffB);
            PG8_WAIT_V(6); PG8_BAR; PG8_MMA(1, 1, At, B1); PG8_BAR;
            PG8_LDB(B0, 1, 0); PG8_SCHED; PG8_LDA(At, 1, 0); PG8_STAGE(PG8_SA(0, 1), a2 + hstep, voffA);
            PG8_WAIT_L(8); PG8_BAR; PG8_WAIT_L(0); PG8_MMA(0, 0, At, B0); PG8_BAR; PG8_SCHED;
            PG8_LDB(B1, 1, 1); PG8_STAGE(PG8_SB(1, 0), b3, voffB);
            PG8_BAR; PG8_WAIT_L(0); PG8_MMA(0, 1, At, B1); PG8_BAR;
            PG8_LDA(At, 1, 1); PG8_STAGE(PG8_SA(1, 0), a3, voffA);
            PG8_BAR; PG8_WAIT_L(0); PG8_MMA(1, 0, At, B0); PG8_BAR; PG8_SCHED;
            PG8_STAGE(PG8_SB(1, 1), b3 + hstep, voffB);
            PG8_WAIT_V(6); PG8_BAR; PG8_MMA(1, 1, At, B1); PG8_BAR;
            }
        }
        if constexpr (ALIGN_EPI) { if (wr == 0) PG8_BAR; }
        if constexpr (!Epi::AFTER_DRAIN) { E(acc, cur, wr, wc, fr, fq); S.done(cur); }
        if (!has_next) break;
#pragma unroll
        for (int a = 0; a < 2; ++a)
#pragma unroll
            for (int b = 0; b < 2; ++b)
#pragma unroll
                for (int m = 0; m < 4; ++m)
#pragma unroll
                    for (int n = 0; n < 2; ++n) acc[a][b][m][n] = (f32x4){0.f, 0.f, 0.f, 0.f};
        cur = nxt; cA = nA; cB = nB; ++ui;
        if constexpr (ALIGN_EPI) { if (wr == 1) PG8_BAR; }
    }
    PG8_WAIT_V(0);
    if constexpr (!ALIGN_EPI) { if (wr == 0) PG8_BAR; }
    PG8_BAR;
    if constexpr (Epi::AFTER_DRAIN) { E.fused(acc, cur, wr, wc, fr, fq, lds, wid, lane); S.done(cur); }
#undef PG8_SA
#undef PG8_SB
#undef PG8_STAGE
#undef PG8_LDA
#undef PG8_LDB
#undef PG8_MMA
#undef PG8_WAIT_V
#undef PG8_WAIT_L
#undef PG8_BAR
#undef PG8_SCHED
}
}

#ifndef REP_K
#define REP_K -1
#endif
#ifndef PHM
#define PHM 0xFFF5
#endif
#ifndef MK_PER_PHASE_LAUNCH
#define MK_PER_PHASE_LAUNCH 0
#endif
#define LAS __attribute__((address_space(3)))
#define GAS __attribute__((address_space(1)))
typedef unsigned short bf16_t;
typedef float f32x4 __attribute__((ext_vector_type(4)));
typedef unsigned u32x4 __attribute__((ext_vector_type(4)));
typedef unsigned u32x2 __attribute__((ext_vector_type(2)));
typedef short bf16x8 __attribute__((ext_vector_type(8)));
typedef float f32x16 __attribute__((ext_vector_type(16)));
typedef float f32x2_t __attribute__((ext_vector_type(2)));
typedef __bf16 bf16x2_t __attribute__((ext_vector_type(2)));

constexpr int DM = 1024, SEQ = 2048, NSEQ = 48, NSEQ_P = 16, MTOK = NSEQ * SEQ, MP = NSEQ_P * SEQ;
constexpr int DEPTH = 4, INW = 1536, DFF = 2816, DPLE = 256;
constexpr float ALPHA = 1.6817928305074290f;
constexpr float LN_EPS = 1e-5f, QK_EPS = 1e-6f;
constexpr float LOG2E = 1.4426950408889634f;
constexpr float QSCALE = 0.125f * LOG2E;
constexpr int NTHREADS = 512, NWAVES = 8;
constexpr int NPHASES = 1 + 8 * DEPTH;

constexpr size_t MiB = (size_t)1 << 20;
constexpr size_t WS_TAB = 0;
constexpr size_t WS_BAR = 98 * MiB;
constexpr size_t WS_PTAB = 99 * MiB;
constexpr size_t WS_W = 1 * MiB;
constexpr size_t W_IN = 0, W_OUT = W_IN + (size_t)INW * DM, W_UP = W_OUT + (size_t)DM * DM, W_DOWN = W_UP + (size_t)2 * DFF * DM,
                 W_PLE = W_DOWN + (size_t)DM * DFF, W_GATE = W_PLE + (size_t)DM * DPLE, W_END = W_GATE + (size_t)DM * DM;
static_assert(W_END * 2 <= 24 * MiB, "weights region");
constexpr size_t WS_P = 25 * MiB;
constexpr size_t WS_EDGE = 73 * MiB;
constexpr size_t EDGE_N = (size_t)(MTOK / 256) * 2 * DFF;
static_assert(WS_EDGE + 3 * EDGE_N * 4 <= 100 * MiB, "edge region");
constexpr size_t WS_X = 100 * MiB;
constexpr size_t WS_H = 292 * MiB;
constexpr size_t WS_O = 580 * MiB;
constexpr size_t WS_VT = 772 * MiB;
constexpr size_t WS_U = 292 * MiB;
constexpr size_t WS_G = 820 * MiB;
constexpr size_t WS_ST = 1012 * MiB;
constexpr size_t WS_NEED = 1013 * MiB;

constexpr int RING_BYTES = 131072, XCH_OFF = RING_BYTES, MISC_OFF = RING_BYTES + 16384 + 2048, LDS_BYTES = MISC_OFF + 256;

struct Params { const float* in[24]; float* out; unsigned char* ws; int ph_lo, ph_hi, rep_k, pad; };
enum { I_XP = 0, I_XS, I_PP, I_PS, I_LN0G, I_LN0B, I_WIN, I_QN, I_KN, I_SINK, I_ONA, I_ONB, I_WOUT, I_LN1G, I_LN1B, I_WUP, I_CW, I_CB, I_WDOWN, I_LN2G, I_LN2B, I_WPLE, I_WGATE, I_BGATE };

template <class T> __device__ __forceinline__ T* as_global(T* p) { return (T*)(GAS T*)p; }
struct UTab { const float* const* t;
    __device__ __forceinline__ const float* operator[](int i) const { const unsigned long long v = (unsigned long long)as_global(t)[i];
        const unsigned lo = __builtin_amdgcn_readfirstlane((unsigned)v), hi = __builtin_amdgcn_readfirstlane((unsigned)(v >> 32)); return as_global((const float*)(((unsigned long long)hi << 32) | lo)); } };
__device__ __forceinline__ unsigned pk2(float lo, float hi) { f32x2_t v = {lo, hi}; bf16x2_t b = __builtin_convertvector(v, bf16x2_t); return __builtin_bit_cast(unsigned, b); }
__device__ __forceinline__ u32x4 pack8(f32x4 a, f32x4 b) { u32x4 w; w.x = pk2(a[0], a[1]); w.y = pk2(a[2], a[3]); w.z = pk2(b[0], b[1]); w.w = pk2(b[2], b[3]); return w; }
__device__ __forceinline__ float bflo(unsigned u) { return __uint_as_float(u << 16); }
__device__ __forceinline__ float bfhi(unsigned u) { return __uint_as_float(u & 0xffff0000u); }
__device__ __forceinline__ void unpack8(u32x4 w, f32x4& a, f32x4& b) { a[0] = bflo(w.x); a[1] = bfhi(w.x); a[2] = bflo(w.y); a[3] = bfhi(w.y); b[0] = bflo(w.z); b[1] = bfhi(w.z); b[2] = bflo(w.w); b[3] = bfhi(w.w); }
__device__ __forceinline__ float wave_sum(float v) {
#pragma unroll
    for (int o = 1; o < 64; o <<= 1) v += __shfl_xor(v, o);
    return v;
}
__device__ __forceinline__ float fast_exp2(float x) { return __builtin_amdgcn_exp2f(x); }
__device__ __forceinline__ float fast_rcp(float x) { return __builtin_amdgcn_rcpf(x); }
__device__ __forceinline__ float gelu_tanh(float c) {
    const float z = c + 0.044715f * c * c * c;
    return c * fast_rcp(1.0f + fast_exp2(-2.3022082f * z));
}
__device__ __forceinline__ float sigmoidf_(float t) { return fast_rcp(1.0f + fast_exp2(-LOG2E * t)); }

__device__ __forceinline__ float dpp_shr1(float v) { return __int_as_float(__builtin_amdgcn_update_dpp(__float_as_int(v), __float_as_int(v), 0x111, 0xf, 0xf, false)); }
__device__ __forceinline__ float dpp_shl1(float v) { return __int_as_float(__builtin_amdgcn_update_dpp(__float_as_int(v), __float_as_int(v), 0x101, 0xf, 0xf, false)); }
struct EpiH {
    static constexpr bool PERM = true, AFTER_DRAIN = false;
    bf16_t* O; int ldc;
    __device__ __forceinline__ void operator()(const f32x4 (&acc)[2][2][4][2], const pg8::Unit& u, int wr, int wc, int fr, int fq) const {
        { int t_ = threadIdx.x; asm volatile("" : "+v"(t_)); fr = t_ & 15; fq = (t_ >> 4) & 3; }
        const int row0 = u.pm * 256 + wr * 64 + fr, col0 = u.pn * 256 + wc * 32 + 8 * fq;
#pragma unroll
        for (int ai = 0; ai < 2; ++ai)
#pragma unroll
            for (int m = 0; m < 4; ++m) { bf16_t* rowp = O + (size_t)(row0 + ai * 128 + m * 16) * ldc + col0;
#pragma unroll
                for (int bj = 0; bj < 2; ++bj) *(GAS u32x4*)(rowp + bj * 128) = pack8(acc[ai][bj][m][0], acc[ai][bj][m][1]); }
    }
};
struct EpiQKV {
    static constexpr bool PERM = true, AFTER_DRAIN = false;
    bf16_t* H; bf16_t* Vt; const float* cos1; const float* sin1; const float* cos2; const float* sin2; const float* qn; const float* kn; LAS float* xch;
    __device__ __forceinline__ void operator()(const f32x4 (&acc)[2][2][4][2], const pg8::Unit& u, int wr, int wc, int fr, int fq) const {
        { int t_ = threadIdx.x; asm volatile("" : "+v"(t_)); fr = t_ & 15; fq = (t_ >> 4) & 3; }
        const int pn = u.pn; const bool grpA = pn < 3, hasV = (pn == 2 || pn == 5), isq = !hasV;
        const int rl0 = wr * 64 + fr;
        if (grpA) {
#pragma unroll
            for (int ai = 0; ai < 2; ++ai)
#pragma unroll
                for (int m = 0; m < 4; ++m)
#pragma unroll
                    for (int bj = 0; bj < 2; ++bj) {
                        const f32x4 a = acc[ai][bj][m][0], b = acc[ai][bj][m][1];
                        float ss = (a[0] * a[0] + a[1] * a[1]) + (a[2] * a[2] + a[3] * a[3]) + (b[0] * b[0] + b[1] * b[1]) + (b[2] * b[2] + b[3] * b[3]);
                        ss += __shfl_xor(ss, 16); ss += __shfl_xor(ss, 32);
                        if (fq == 0) xch[((rl0 + ai * 128 + m * 16) * 2 + bj) * 4 + wc] = ss;
                    }
            asm volatile("s_waitcnt lgkmcnt(0)" ::: "memory"); __builtin_amdgcn_s_barrier(); asm volatile("" ::: "memory");
        }
        const int dbase = 32 * (wc & 1) + 8 * fq, i0 = 16 * (wc & 1) + 4 * fq, col0 = pn * 256 + wc * 32 + 8 * fq;
        const float* ctab = grpA ? cos2 : cos1; const float* stab = grpA ? sin2 : sin1;
        f32x4 gn0 = (f32x4){1.f, 1.f, 1.f, 1.f}, gn1 = gn0;
        if (grpA) { const float* gn = (isq ? qn : kn) + dbase; gn0 = *(const GAS f32x4*)gn; gn1 = *(const GAS f32x4*)(gn + 4); }
#pragma unroll
        for (int ai = 0; ai < 2; ++ai) {
            f32x4 c4v[4], s4v[4];
#pragma unroll
            for (int m = 0; m < 4; ++m) { const int pos = (u.pm * 256 + rl0 + ai * 128 + m * 16) & (SEQ - 1);
                c4v[m] = *(const GAS f32x4*)(ctab + pos * 32 + i0); s4v[m] = *(const GAS f32x4*)(stab + pos * 32 + i0); }
#pragma unroll
            for (int m = 0; m < 4; ++m) {
                const int rl = rl0 + ai * 128 + m * 16, row = u.pm * 256 + rl, pos = row & (SEQ - 1);
                const f32x4 c4 = c4v[m], s4 = s4v[m];
#pragma unroll
                for (int bj = 0; bj < 2; ++bj) {
                    f32x4 a = acc[ai][bj][m][0], b = acc[ai][bj][m][1];
                    if (hasV && bj == 1) {
                        bf16_t* vp = Vt + ((size_t)((((pn == 5 ? 1 : 0) * NSEQ + (row >> 11)) * 2 + (wc >> 1)) * 64 + dbase)) * SEQ + pos;
                        const u32x4 w = pack8(a, b);
                        *(GAS bf16_t*)(vp + 0 * SEQ) = (bf16_t)(w.x & 0xffffu); *(GAS bf16_t*)(vp + 1 * SEQ) = (bf16_t)(w.x >> 16);
                        *(GAS bf16_t*)(vp + 2 * SEQ) = (bf16_t)(w.y & 0xffffu); *(GAS bf16_t*)(vp + 3 * SEQ) = (bf16_t)(w.y >> 16);
                        *(GAS bf16_t*)(vp + 4 * SEQ) = (bf16_t)(w.z & 0xffffu); *(GAS bf16_t*)(vp + 5 * SEQ) = (bf16_t)(w.z >> 16);
                        *(GAS bf16_t*)(vp + 6 * SEQ) = (bf16_t)(w.w & 0xffffu); *(GAS bf16_t*)(vp + 7 * SEQ) = (bf16_t)(w.w >> 16);
                    } else {
                        if (grpA) {
                            const LAS float* xp = xch + (rl * 2 + bj) * 4 + (wc & 2);
                            const float tot = xp[0] + xp[1];
                            const float rstd = __builtin_amdgcn_rsqf(tot * (1.f / 64.f) + QK_EPS);
                            a = a * rstd * gn0; b = b * rstd * gn1;
                        }
                        f32x4 oa, ob;
                        oa[0] = a[0] * c4[0] - a[1] * s4[0]; oa[1] = a[0] * s4[0] + a[1] * c4[0];
                        oa[2] = a[2] * c4[1] - a[3] * s4[1]; oa[3] = a[2] * s4[1] + a[3] * c4[1];
                        ob[0] = b[0] * c4[2] - b[1] * s4[2]; ob[1] = b[0] * s4[2] + b[1] * c4[2];
                        ob[2] = b[2] * c4[3] - b[3] * s4[3]; ob[3] = b[2] * s4[3] + b[3] * c4[3];
                        if (isq) { oa = oa * QSCALE; ob = ob * QSCALE; }
                        *(GAS u32x4*)(H + (size_t)row * INW + col0 + bj * 128) = pack8(oa, ob);
                    }
                }
            }
            asm volatile("" ::: "memory");
        }
    }
};
template <bool HASG> struct EpiRes {
    static constexpr bool PERM = true, AFTER_DRAIN = false;
    const bf16_t* X; const bf16_t* G; float* Y; bf16_t* Yb; bool yf32; bool fromY; const float* ST; const float* lng; const float* lnb; bf16_t* Yw;
    __device__ __forceinline__ void operator()(const f32x4 (&acc)[2][2][4][2], const pg8::Unit& u, int wr, int wc, int fr, int fq) const {
        { int t_ = threadIdx.x; asm volatile("" : "+v"(t_)); fr = t_ & 15; fq = (t_ >> 4) & 3; }
        const int row0 = u.pm * 256 + wr * 64 + fr, col0 = u.pn * 256 + wc * 32 + 8 * fq;
#pragma unroll
        for (int bj = 0; bj < 2; ++bj) {
            f32x4 g0, g1, b0, b1;
            if (fromY) { g0 = *(const GAS f32x4*)(lng + col0 + bj * 128); g1 = *(const GAS f32x4*)(lng + col0 + bj * 128 + 4); b0 = *(const GAS f32x4*)(lnb + col0 + bj * 128); b1 = *(const GAS f32x4*)(lnb + col0 + bj * 128 + 4); }
#pragma unroll
            for (int ai = 0; ai < 2; ++ai) {
                u32x4 win[4], wg[4]; float smean[4], srstd[4];
#pragma unroll
                for (int m = 0; m < 4; ++m) {
                    const int row = row0 + ai * 128 + m * 16; const size_t off = (size_t)row * DM + col0 + bj * 128;
                    if (fromY) { typedef float f2_ __attribute__((ext_vector_type(2))); const f2_ st = *(const GAS f2_*)(ST + 2 * (size_t)row); smean[m] = st[0]; srstd[m] = st[1]; win[m] = *(const GAS u32x4*)(Yb + off); }
                    else { smean[m] = 0.f; srstd[m] = 1.f; win[m] = *(const GAS u32x4*)(X + off); }
                    if (HASG) wg[m] = *(const GAS u32x4*)(G + off);
                }
#pragma unroll
                for (int m = 0; m < 4; ++m) {
                    const int row = row0 + ai * 128 + m * 16; const size_t off = (size_t)row * DM + col0 + bj * 128;
                    f32x4 xa, xb; unpack8(win[m], xa, xb);
                    if (fromY) { xa = (xa - smean[m]) * srstd[m] * g0 + b0; xb = (xb - smean[m]) * srstd[m] * g1 + b1; }
                    f32x4 y0 = xa * ALPHA + acc[ai][bj][m][0], y1 = xb * ALPHA + acc[ai][bj][m][1];
                    if (HASG) { f32x4 ga, gb; unpack8(wg[m], ga, gb); y0 += ga; y1 += gb; }
                    if (yf32) { *(GAS f32x4*)(Y + off) = y0; *(GAS f32x4*)(Y + off + 4) = y1; }
                    else *(GAS u32x4*)(Yw + off) = pack8(y0, y1);
                }
                asm volatile("" ::: "memory");
            }
        }
    }
};
struct EpiGate {
    static constexpr bool PERM = true, AFTER_DRAIN = false;
    bf16_t* G; const float* bias;
    __device__ __forceinline__ void operator()(const f32x4 (&acc)[2][2][4][2], const pg8::Unit& u, int wr, int wc, int fr, int fq) const {
        { int t_ = threadIdx.x; asm volatile("" : "+v"(t_)); fr = t_ & 15; fq = (t_ >> 4) & 3; }
        const int row0 = u.pm * 256 + wr * 64 + fr, col0 = u.pn * 256 + wc * 32 + 8 * fq;
#pragma unroll
        for (int bj = 0; bj < 2; ++bj) {
            const f32x4 bv0 = *(const GAS f32x4*)(bias + col0 + bj * 128), bv1 = *(const GAS f32x4*)(bias + col0 + bj * 128 + 4);
#pragma unroll
            for (int ai = 0; ai < 2; ++ai)
#pragma unroll
                for (int m = 0; m < 4; ++m) {
                    const size_t off = (size_t)(row0 + ai * 128 + m * 16) * DM + col0 + bj * 128;
                    f32x4 a = acc[ai][bj][m][0] + bv0, b = acc[ai][bj][m][1] + bv1;
#pragma unroll
                    for (int j = 0; j < 4; ++j) { a[j] = sigmoidf_(a[j]); b[j] = sigmoidf_(b[j]); }
                    *(GAS u32x4*)(G + off) = pack8(a, b);
                    asm volatile("" ::: "memory");
                }
        }
    }
};
struct EpiPle {
    static constexpr bool PERM = true, AFTER_DRAIN = false;
    bf16_t* G;
    __device__ __forceinline__ void operator()(const f32x4 (&acc)[2][2][4][2], const pg8::Unit& u, int wr, int wc, int fr, int fq) const {
        { int t_ = threadIdx.x; asm volatile("" : "+v"(t_)); fr = t_ & 15; fq = (t_ >> 4) & 3; }
        const int row0 = u.pm * 256 + wr * 64 + fr, col0 = u.pn * 256 + wc * 32 + 8 * fq;
#pragma unroll
        for (int ai = 0; ai < 2; ++ai)
#pragma unroll
            for (int bj = 0; bj < 2; ++bj) {
                u32x4 wg[4];
#pragma unroll
                for (int m = 0; m < 4; ++m) wg[m] = *(const GAS u32x4*)(G + (size_t)(row0 + ai * 128 + m * 16) * DM + col0 + bj * 128);
#pragma unroll
                for (int m = 0; m < 4; ++m) {
                    f32x4 ga, gb; unpack8(wg[m], ga, gb);
                    *(GAS u32x4*)(G + (size_t)(row0 + ai * 128 + m * 16) * DM + col0 + bj * 128) = pack8(ga * acc[ai][bj][m][0], gb * acc[ai][bj][m][1]);
                }
                asm volatile("" ::: "memory");
            }
    }
};
struct EpiUp {
    static constexpr bool PERM = true, AFTER_DRAIN = false;
    bf16_t* U; float* EG; float* EC; float* EV; const float* cw; const float* cb; LAS float* xch;
    __device__ __forceinline__ void operator()(const f32x4 (&acc)[2][2][4][2], const pg8::Unit& u, int wr, int wc, int fr, int fq) const {
        { int t_ = threadIdx.x; asm volatile("" : "+v"(t_)); fr = t_ & 15; fq = (t_ >> 4) & 3; }
        const int chl = wc * 32 + 8 * fq, ch0 = u.pn * 128 + chl;
        LAS float* first = xch; LAS float* last = xch + 16 * 128; LAS float* cst = xch + 32 * 128;
        { int t_ = threadIdx.x; asm volatile("" : "+v"(t_)); const int kk = t_ >> 7, cc = t_ & 127;
          cst[t_] = (kk < 3) ? *(const GAS float*)(cw + kk * DFF + u.pn * 128 + cc) : *(const GAS float*)(cb + u.pn * 128 + cc); }
#pragma unroll
        for (int ai = 0; ai < 2; ++ai)
#pragma unroll
            for (int m = 0; m < 4; ++m) { const int grp = ai * 8 + wr * 4 + m;
                if (fr == 0) { *(LAS f32x4*)(first + grp * 128 + chl) = acc[ai][0][m][0]; *(LAS f32x4*)(first + grp * 128 + chl + 4) = acc[ai][0][m][1]; }
                if (fr == 15) { *(LAS f32x4*)(last + grp * 128 + chl) = acc[ai][0][m][0]; *(LAS f32x4*)(last + grp * 128 + chl + 4) = acc[ai][0][m][1]; } }
        asm volatile("s_waitcnt lgkmcnt(0)" ::: "memory"); __builtin_amdgcn_s_barrier(); asm volatile("" ::: "memory");
#pragma unroll
        for (int ai = 0; ai < 2; ++ai)
#pragma unroll
            for (int m = 0; m < 4; ++m) {
                const int grp = ai * 8 + wr * 4 + m;
                const f32x4 g0 = acc[ai][0][m][0], g1 = acc[ai][0][m][1], v0 = acc[ai][1][m][0], v1 = acc[ai][1][m][1];
                f32x4 up0, up1, dn0, dn1;
#pragma unroll
                for (int j = 0; j < 4; ++j) { up0[j] = dpp_shr1(g0[j]); up1[j] = dpp_shr1(g1[j]); dn0[j] = dpp_shl1(g0[j]); dn1[j] = dpp_shl1(g1[j]); }
                const int gp = grp > 0 ? grp - 1 : 0, gn = grp < 15 ? grp + 1 : 15;
                f32x4 l0 = *(const LAS f32x4*)(last + gp * 128 + chl), l1 = *(const LAS f32x4*)(last + gp * 128 + chl + 4);
                f32x4 f0 = *(const LAS f32x4*)(first + gn * 128 + chl), f1 = *(const LAS f32x4*)(first + gn * 128 + chl + 4);
                if (grp == 0) { l0 = (f32x4){0.f, 0.f, 0.f, 0.f}; l1 = l0; }
                if (grp == 15) { f0 = (f32x4){0.f, 0.f, 0.f, 0.f}; f1 = f0; }
                if (fr == 0) { up0 = l0; up1 = l1; }
                if (fr == 15) { dn0 = f0; dn1 = f1; }
                f32x4 c0, c1;
                { const f32x4 w0a = *(const LAS f32x4*)(cst + chl), w1a = *(const LAS f32x4*)(cst + 128 + chl), w2a = *(const LAS f32x4*)(cst + 256 + chl), cba = *(const LAS f32x4*)(cst + 384 + chl);
                  c0 = w0a * up0 + w1a * g0 + w2a * dn0 + cba; }
                { const f32x4 w0b = *(const LAS f32x4*)(cst + chl + 4), w1b = *(const LAS f32x4*)(cst + 128 + chl + 4), w2b = *(const LAS f32x4*)(cst + 256 + chl + 4), cbb = *(const LAS f32x4*)(cst + 384 + chl + 4);
                  c1 = w0b * up1 + w1b * g1 + w2b * dn1 + cbb; }
                f32x4 u0, u1;
#pragma unroll
                for (int j = 0; j < 4; ++j) { u0[j] = gelu_tanh(c0[j]) * v0[j]; u1[j] = gelu_tanh(c1[j]) * v1[j]; }
                const int row = u.pm * 256 + grp * 16 + fr;
                *(GAS u32x4*)(U + (size_t)row * DFF + ch0) = pack8(u0, u1);
                if (grp == 0 && fr == 0) { const size_t e = ((size_t)u.pm * 2 + 0) * DFF + ch0;
                    *(GAS f32x4*)(EG + e) = g0; *(GAS f32x4*)(EG + e + 4) = g1; *(GAS f32x4*)(EC + e) = c0; *(GAS f32x4*)(EC + e + 4) = c1; *(GAS f32x4*)(EV + e) = v0; *(GAS f32x4*)(EV + e + 4) = v1; }
                if (grp == 15 && fr == 15) { const size_t e = ((size_t)u.pm * 2 + 1) * DFF + ch0;
                    *(GAS f32x4*)(EG + e) = g0; *(GAS f32x4*)(EG + e + 4) = g1; *(GAS f32x4*)(EC + e) = c0; *(GAS f32x4*)(EC + e + 4) = c1; *(GAS f32x4*)(EV + e) = v0; *(GAS f32x4*)(EV + e + 4) = v1; }
                asm volatile("" ::: "memory");
            }
    }
};

__device__ __forceinline__ void ln_row(const float* src, const float* g, const float* b, bf16_t* dstb, float* dstf, int lane) {
    const f32x4* xr = (const f32x4*)src + lane;
    f32x4 v[4]; float s = 0.f;
#pragma unroll
    for (int j = 0; j < 4; ++j) { v[j] = xr[64 * j]; s += (v[j][0] + v[j][1]) + (v[j][2] + v[j][3]); }
    const float mean = wave_sum(s) * (1.f / DM); float s2 = 0.f;
#pragma unroll
    for (int j = 0; j < 4; ++j) { v[j] = v[j] - mean; s2 += (v[j][0] * v[j][0] + v[j][1] * v[j][1]) + (v[j][2] * v[j][2] + v[j][3] * v[j][3]); }
    const float rstd = 1.f / sqrtf(wave_sum(s2) * (1.f / DM) + LN_EPS);
#pragma unroll
    for (int j = 0; j < 4; ++j) {
        const f32x4 gg = ((const GAS f32x4*)g)[lane + 64 * j], bb = ((const GAS f32x4*)b)[lane + 64 * j];
        const f32x4 o = v[j] * rstd * gg + bb;
        if (dstf) ((GAS f32x4*)dstf)[lane + 64 * j] = o;
        if (dstb) { u32x2 w; w.x = pk2(o[0], o[1]); w.y = pk2(o[2], o[3]); ((GAS u32x2*)dstb)[lane + 64 * j] = w; }
    }
}

__device__ __forceinline__ void ln_rows4(const float* src0, const float* g, const float* b, bf16_t* dstb0, float* dstf0, int lane) {
    f32x4 v[4][4]; float s[4], s2[4];
#pragma unroll
    for (int r = 0; r < 4; ++r)
#pragma unroll
        for (int j = 0; j < 4; ++j) v[r][j] = ((const GAS f32x4*)(src0 + (size_t)r * DM))[lane + 64 * j];
#pragma unroll
    for (int r = 0; r < 4; ++r) { s[r] = 0.f;
#pragma unroll
        for (int j = 0; j < 4; ++j) s[r] += (v[r][j][0] + v[r][j][1]) + (v[r][j][2] + v[r][j][3]); }
#pragma unroll
    for (int o = 1; o < 64; o <<= 1)
#pragma unroll
        for (int r = 0; r < 4; ++r) s[r] += __shfl_xor(s[r], o);
#pragma unroll
    for (int r = 0; r < 4; ++r) { const float mean = s[r] * (1.f / DM); s2[r] = 0.f;
#pragma unroll
        for (int j = 0; j < 4; ++j) { v[r][j] = v[r][j] - mean; s2[r] += (v[r][j][0] * v[r][j][0] + v[r][j][1] * v[r][j][1]) + (v[r][j][2] * v[r][j][2] + v[r][j][3] * v[r][j][3]); } }
#pragma unroll
    for (int o = 1; o < 64; o <<= 1)
#pragma unroll
        for (int r = 0; r < 4; ++r) s2[r] += __shfl_xor(s2[r], o);
#pragma unroll
    for (int j = 0; j < 4; ++j) {
        const f32x4 gg = ((const GAS f32x4*)g)[lane + 64 * j], bb = ((const GAS f32x4*)b)[lane + 64 * j];
#pragma unroll
        for (int r = 0; r < 4; ++r) {
            const float rstd = 1.f / sqrtf(s2[r] * (1.f / DM) + LN_EPS);
            const f32x4 o = v[r][j] * rstd * gg + bb;
            if (dstf0) ((GAS f32x4*)(dstf0 + (size_t)r * DM))[lane + 64 * j] = o;
            if (dstb0) { u32x2 w; w.x = pk2(o[0], o[1]); w.y = pk2(o[2], o[3]); ((GAS u32x2*)(dstb0 + (size_t)r * DM))[lane + 64 * j] = w; }
        }
    }
}

__device__ __forceinline__ void ln_rows4_bf16(const bf16_t* src0, const float* g, const float* b, bf16_t* dstb0, float* st0, int lane, float* dstf0 = nullptr) {
    u32x4 w[4][2]; f32x4 v[4][4]; float s[4], s2[4];
#pragma unroll
    for (int r = 0; r < 4; ++r) { w[r][0] = *(const GAS u32x4*)(src0 + (size_t)r * DM + 8 * lane); w[r][1] = *(const GAS u32x4*)(src0 + (size_t)r * DM + 512 + 8 * lane); }
#pragma unroll
    for (int r = 0; r < 4; ++r) { unpack8(w[r][0], v[r][0], v[r][1]); unpack8(w[r][1], v[r][2], v[r][3]); s[r] = 0.f;
#pragma unroll
        for (int j = 0; j < 4; ++j) s[r] += (v[r][j][0] + v[r][j][1]) + (v[r][j][2] + v[r][j][3]); }
#pragma unroll
    for (int o = 1; o < 64; o <<= 1)
#pragma unroll
        for (int r = 0; r < 4; ++r) s[r] += __shfl_xor(s[r], o);
#pragma unroll
    for (int r = 0; r < 4; ++r) { const float mean = s[r] * (1.f / DM); s2[r] = 0.f;
#pragma unroll
        for (int j = 0; j < 4; ++j) { v[r][j] = v[r][j] - mean; s2[r] += (v[r][j][0] * v[r][j][0] + v[r][j][1] * v[r][j][1]) + (v[r][j][2] * v[r][j][2] + v[r][j][3] * v[r][j][3]); } }
#pragma unroll
    for (int o = 1; o < 64; o <<= 1)
#pragma unroll
        for (int r = 0; r < 4; ++r) s2[r] += __shfl_xor(s2[r], o);
    f32x4 gg[4], bb[4];
#pragma unroll
    for (int j = 0; j < 4; ++j) { const int c = (j >> 1) * 512 + 8 * lane + 4 * (j & 1); gg[j] = *(const GAS f32x4*)(g + c); bb[j] = *(const GAS f32x4*)(b + c); }
#pragma unroll
    for (int r = 0; r < 4; ++r) {
        const float rstd = 1.f / sqrtf(s2[r] * (1.f / DM) + LN_EPS);
        if (st0 && lane == 0) { typedef float f2_ __attribute__((ext_vector_type(2))); *(GAS f2_*)(st0 + 2 * r) = (f2_){s[r] * (1.f / DM), rstd}; }
        f32x4 o[4];
#pragma unroll
        for (int j = 0; j < 4; ++j) o[j] = v[r][j] * rstd * gg[j] + bb[j];
        if (dstf0) { float* dr = dstf0 + (size_t)r * DM + 8 * lane; *(GAS f32x4*)dr = o[0]; *(GAS f32x4*)(dr + 4) = o[1]; *(GAS f32x4*)(dr + 512) = o[2]; *(GAS f32x4*)(dr + 516) = o[3]; }
        else { *(GAS u32x4*)(dstb0 + (size_t)r * DM + 8 * lane) = pack8(o[0], o[1]); *(GAS u32x4*)(dstb0 + (size_t)r * DM + 512 + 8 * lane) = pack8(o[2], o[3]); }
    }
}

__device__ __forceinline__ void transpose_item(const float* W, int K, int N, bf16_t* WT, LAS float* scr, int item, int lane, bool upmap) {
    const int nblk = N / 32, kb = item / nblk, nb = item % nblk, k0 = 64 * kb, n0 = 32 * nb;
    { float tv[32];
#pragma unroll
      for (int i = 0; i < 32; ++i) tv[i] = ((const GAS float*)W)[(size_t)(k0 + 2 * i + (lane >> 5)) * N + n0 + (lane & 31)];
#pragma unroll
      for (int i = 0; i < 32; ++i) scr[(2 * i + (lane >> 5)) * 33 + (lane & 31)] = tv[i]; }
    asm volatile("s_waitcnt lgkmcnt(0)" ::: "memory");
    int d0 = n0;
    if (upmap) { const int bj = n0 >= DFF ? 1 : 0, c = n0 - bj * DFF; d0 = 256 * (c / 128) + 128 * bj + (c % 128); }
    const int c = lane & 7;
#pragma unroll
    for (int j = 0; j < 4; ++j) { const int n = (lane >> 3) + 8 * j; const LAS float* s = scr + (8 * c) * 33 + n;
        u32x4 o; o.x = pk2(s[0 * 33], s[1 * 33]); o.y = pk2(s[2 * 33], s[3 * 33]); o.z = pk2(s[4 * 33], s[5 * 33]); o.w = pk2(s[6 * 33], s[7 * 33]);
        *(GAS u32x4*)(WT + (size_t)(d0 + n) * K + k0 + 8 * c) = o; }
    asm volatile("s_waitcnt lgkmcnt(0)" ::: "memory");
}

template <class TAB> __device__ __forceinline__ void convert_layer(const TAB& in, unsigned char* ws, int l, LAS unsigned char* lds, int gw, int NGW, int wave, int lane, size_t gt, size_t NT) {
    LAS float* scr = (LAS float*)(lds + wave * 16384);
    bf16_t* Wl = (bf16_t*)(ws + WS_W);
    constexpr int I_IN = (DM / 64) * (INW / 32), I_OUT = (DM / 64) * (DM / 32), I_UP = (DM / 64) * (2 * DFF / 32), I_DOWN = (DFF / 64) * (DM / 32), I_PLE = (DPLE / 64) * (DM / 32), I_GATE = I_OUT;
    constexpr int NITEMS = I_IN + I_OUT + I_UP + I_DOWN + I_PLE + I_GATE;
    for (int it = gw; it < NITEMS; it += NGW) {
        int r = it;
        if (r < I_IN) { transpose_item(in[I_WIN] + (size_t)l * DM * INW, DM, INW, Wl + W_IN, scr, r, lane, false); continue; } r -= I_IN;
        if (r < I_OUT) { transpose_item(in[I_WOUT] + (size_t)l * DM * DM, DM, DM, Wl + W_OUT, scr, r, lane, false); continue; } r -= I_OUT;
        if (r < I_UP) { transpose_item(in[I_WUP] + (size_t)l * DM * 2 * DFF, DM, 2 * DFF, Wl + W_UP, scr, r, lane, true); continue; } r -= I_UP;
        if (r < I_DOWN) { transpose_item(in[I_WDOWN] + (size_t)l * DFF * DM, DFF, DM, Wl + W_DOWN, scr, r, lane, false); continue; } r -= I_DOWN;
        if (r < I_PLE) { transpose_item(in[I_WPLE] + (size_t)l * DPLE * DM, DPLE, DM, Wl + W_PLE, scr, r, lane, false); continue; } r -= I_PLE;
        transpose_item(in[I_WGATE] + (size_t)l * DM * DM, DM, DM, Wl + W_GATE, scr, r, lane, false);
    }
    bf16_t* Pb = (bf16_t*)(ws + WS_P);
    const size_t NV8 = (size_t)MTOK * (DPLE / 8);
    size_t i = gt;
    for (; i + 3 * NT < NV8; i += 4 * NT) {
        f32x4 va[4], vb[4];
#pragma unroll
        for (int u = 0; u < 4; ++u) { const size_t ii = i + u * NT, m = ii / (DPLE / 8), c8 = ii % (DPLE / 8);
            const float* src = (m < (size_t)MP) ? in[I_PP] + ((size_t)l * MP + m) * DPLE : in[I_PS] + ((size_t)l * (MTOK - MP) + (m - MP)) * DPLE;
            va[u] = *(const GAS f32x4*)(src + 8 * c8); vb[u] = *(const GAS f32x4*)(src + 8 * c8 + 4); }
#pragma unroll
        for (int u = 0; u < 4; ++u) { const size_t ii = i + u * NT, m = ii / (DPLE / 8), c8 = ii % (DPLE / 8);
            *(GAS u32x4*)(Pb + m * DPLE + 8 * c8) = pack8(va[u], vb[u]); }
    }
    for (; i < NV8; i += NT) {
        const size_t m = i / (DPLE / 8), c8 = i % (DPLE / 8);
        const float* src = (m < (size_t)MP) ? in[I_PP] + ((size_t)l * MP + m) * DPLE : in[I_PS] + ((size_t)l * (MTOK - MP) + (m - MP)) * DPLE;
        *(GAS u32x4*)(Pb + m * DPLE + 8 * c8) = pack8(*(const GAS f32x4*)(src + 8 * c8), *(const GAS f32x4*)(src + 8 * c8 + 4));
    }
}

namespace att {
constexpr int ROWB = 144, TILEB = 64 * ROWB;
__device__ __forceinline__ int pi_slot(int s) { return (s & 3) + 4 * ((s >> 3) & 1) + 8 * ((s >> 2) & 1) + 16 * (s >> 4); }
#define MFMA32(a, b, c) __builtin_amdgcn_mfma_f32_32x32x16_bf16((a), (b), (c), 0, 0, 0)
__device__ __forceinline__ float max3f(float a, float b, float c) { return fmaxf(fmaxf(a, b), c); }
template <bool WIN>
__device__ __forceinline__ void attn_unit(LAS unsigned char* lds, const bf16_t* __restrict__ H, const bf16_t* __restrict__ Vt, bf16_t* __restrict__ O, int b, int qblk, const float* sinkp, const float* gainp, bool nomax) {
    int tid_ = threadIdx.x; asm volatile("" : "+v"(tid_));
    const int tid = tid_, lane = tid & 63, r32 = lane & 31, hi = lane >> 5, wid = tid >> 6;
    const int q0 = 64 * qblk, head = wid, kh = wid >> 2;
    const size_t rowbase = (size_t)b * SEQ;
    const bf16_t* Qp = H + (rowbase + q0 + r32) * INW + (WIN ? 768 : 0) + head * 64 + 8 * hi;
    bf16x8 qf[2][4];
#pragma unroll
    for (int qs = 0; qs < 2; ++qs)
#pragma unroll
        for (int c = 0; c < 4; ++c) qf[qs][c] = *(const GAS bf16x8*)(Qp + (size_t)(32 * qs) * INW + 16 * c);
    const int lrow = tid >> 3, lch = tid & 7;
    const bf16_t* Kp = H + (rowbase + lrow) * INW + (WIN ? 1280 : 512) + 8 * lch;
    const bf16_t* Vp = Vt + ((size_t)(((WIN ? 1 : 0) * NSEQ + b) * 2) * 64 + lrow) * SEQ + 8 * lch;
    const int t_lo = WIN ? (qblk - 2 < 0 ? 0 : qblk - 2) : 0, t_hi = WIN ? (qblk + 2 > 31 ? 31 : qblk + 2) : 31;
    LAS unsigned char* Kl = lds; LAS unsigned char* Vl = lds + 4 * TILEB;
    const int stoff = lrow * ROWB + lch * 16;
    float mrun[2], lrun[2]; f32x16 o[2][2];
#pragma unroll
    for (int qs = 0; qs < 2; ++qs) {
        if (WIN) { mrun[qs] = sinkp[head] * LOG2E; lrun[qs] = hi == 0 ? 1.f : 0.f; } else { mrun[qs] = 0.f; lrun[qs] = 0.f; }
#pragma unroll
        for (int dh = 0; dh < 2; ++dh)
#pragma unroll
            for (int r = 0; r < 16; ++r) o[qs][dh][r] = 0.f;
    }
    u32x4 kreg[2], vreg[2];
#pragma unroll
    for (int kk = 0; kk < 2; ++kk) { kreg[kk] = *(const GAS u32x4*)(Kp + (size_t)(64 * t_lo) * INW + 64 * kk); vreg[kk] = *(const GAS u32x4*)(Vp + 64 * t_lo + (size_t)kk * 64 * SEQ); }
#pragma unroll
    for (int kk = 0; kk < 2; ++kk) { *(LAS u32x4*)(Kl + kk * TILEB + stoff) = kreg[kk]; *(LAS u32x4*)(Vl + kk * TILEB + stoff) = vreg[kk]; }
    __syncthreads();
    const int koff = pi_slot(r32) * ROWB + 16 * hi, voff = r32 * ROWB + 16 * hi;
    for (int t = t_lo; t <= t_hi; ++t) {
        const int buf = (t - t_lo) & 1;
        if (t < t_hi) {
#pragma unroll
            for (int kk = 0; kk < 2; ++kk) { kreg[kk] = *(const GAS u32x4*)(Kp + (size_t)(64 * (t + 1)) * INW + 64 * kk); vreg[kk] = *(const GAS u32x4*)(Vp + 64 * (t + 1) + (size_t)kk * 64 * SEQ); }
        }
        const LAS unsigned char* Kb = Kl + (2 * buf + kh) * TILEB; const LAS unsigned char* Vb = Vl + (2 * buf + kh) * TILEB;
        const bool mk = WIN && (t < qblk - 1 || t > qblk + 1);
        bf16x8 kf[4]; bf16x8 vf[2][2]; f32x16 pq[2][2];
#define ATT_LDK(H2) do { _Pragma("unroll") for (int c = 0; c < 4; ++c) kf[c] = *(const LAS bf16x8*)(Kb + (H2) * 32 * ROWB + koff + 32 * c); } while (0)
#define ATT_LDV(H2) do { _Pragma("unroll") for (int dh = 0; dh < 2; ++dh) _Pragma("unroll") for (int s_ = 0; s_ < 2; ++s_) vf[dh][s_] = *(const LAS bf16x8*)(Vb + dh * 32 * ROWB + voff + 32 * (2 * (H2) + s_)); } while (0)
#define ATT_QK(H2, QS) do { _Pragma("unroll") for (int r = 0; r < 16; ++r) pq[H2][QS][r] = 0.f; _Pragma("unroll") for (int c = 0; c < 4; ++c) pq[H2][QS] = MFMA32(kf[c], qf[QS][c], pq[H2][QS]); } while (0)
#define ATT_SMPV(H2, QS) do { \
            f32x16 d; \
            if (!WIN && nomax) d = pq[H2][QS];     \
            else { \
            const float nm_ = -mrun[QS]; \
            d = pq[H2][QS] + nm_; \
            if (mk) { const int q = q0 + 32 * (QS) + r32; \
                _Pragma("unroll") for (int r = 0; r < 16; ++r) { const int key = 64 * t + 32 * (H2) + (r & 3) + 4 * ((r >> 2) & 1) + 8 * hi + 16 * (r >> 3); const int dd = key - q; if (dd > 128 || dd < -128) d[r] = -INFINITY; } } \
            float mx; \
            { float a = max3f(d[0], d[1], d[2]), b = max3f(d[3], d[4], d[5]); \
              a = max3f(a, d[6], d[7]); b = max3f(b, d[8], d[9]); a = max3f(a, d[10], d[11]); b = max3f(b, d[12], d[13]); a = max3f(a, d[14], d[15]); mx = fmaxf(a, b); } \
            { auto rr = __builtin_amdgcn_permlane32_swap(__float_as_uint(mx), __float_as_uint(mx), false, false); mx = fmaxf(__uint_as_float(rr[0]), __uint_as_float(rr[1])); } \
            const bool first = !WIN && (H2) == 0 && t == t_lo; \
            if (first || __any(mx > 8.f)) {     \
                const float dl = first ? mx : fmaxf(mx, 0.f); \
                const float alpha = fast_exp2(-dl); \
                mrun[QS] += dl; lrun[QS] *= alpha; \
                _Pragma("unroll") for (int dh = 0; dh < 2; ++dh) _Pragma("unroll") for (int r = 0; r < 16; ++r) o[QS][dh][r] *= alpha; \
                { const float ndl = -dl; d = d + ndl; } \
            } \
            } \
            _Pragma("unroll") for (int r = 0; r < 16; ++r) d[r] = fast_exp2(d[r]); \
            { typedef float f32x8 __attribute__((ext_vector_type(8))); \
              const f32x8 s8 = __builtin_shufflevector(d, d, 0, 1, 2, 3, 4, 5, 6, 7) + __builtin_shufflevector(d, d, 8, 9, 10, 11, 12, 13, 14, 15); \
              const f32x4 s4 = __builtin_shufflevector(s8, s8, 0, 1, 2, 3) + __builtin_shufflevector(s8, s8, 4, 5, 6, 7); \
              lrun[QS] += (s4[0] + s4[1]) + (s4[2] + s4[3]); } \
            u32x4 pb0, pb1; \
            _Pragma("unroll") for (int w = 0; w < 4; ++w) { pb0[w] = pk2(d[2 * w], d[2 * w + 1]); pb1[w] = pk2(d[8 + 2 * w], d[8 + 2 * w + 1]); } \
            _Pragma("unroll") for (int dh = 0; dh < 2; ++dh) { \
                o[QS][dh] = MFMA32(vf[dh][0], __builtin_bit_cast(bf16x8, pb0), o[QS][dh]); \
                o[QS][dh] = MFMA32(vf[dh][1], __builtin_bit_cast(bf16x8, pb1), o[QS][dh]); } \
        } while (0)
        ATT_LDK(0); ATT_QK(0, 0); ATT_QK(0, 1); ATT_LDV(0);
        ATT_SMPV(0, 0); ATT_LDK(1); ATT_QK(1, 0);
        ATT_SMPV(0, 1); ATT_QK(1, 1); ATT_LDV(1);
        ATT_SMPV(1, 0);
        ATT_SMPV(1, 1);
#undef ATT_LDK
#undef ATT_LDV
#undef ATT_QK
#undef ATT_SMPV
        if (t < t_hi) {
#pragma unroll
            for (int kk = 0; kk < 2; ++kk) { *(LAS u32x4*)(Kl + (2 * (buf ^ 1) + kk) * TILEB + stoff) = kreg[kk]; *(LAS u32x4*)(Vl + (2 * (buf ^ 1) + kk) * TILEB + stoff) = vreg[kk]; }
        }
        __syncthreads();
    }
    LAS float* xs = (LAS float*)(lds + 8 * TILEB);
#pragma unroll
    for (int qs = 0; qs < 2; ++qs) {
        const float lt = lrun[qs] + __shfl_xor(lrun[qs], 32);
        const float inv = 1.0f / lt;
        float ss = 0.f;
#pragma unroll
        for (int dh = 0; dh < 2; ++dh)
#pragma unroll
            for (int r = 0; r < 16; ++r) { const float v = o[qs][dh][r] * inv; o[qs][dh][r] = v; ss += v * v; }
        ss += __shfl_xor(ss, 32);
        if (hi == 0) xs[(32 * qs + r32) * 8 + wid] = ss;
    }
    __syncthreads();
#pragma unroll
    for (int qs = 0; qs < 2; ++qs) {
        const f32x4 x0 = *(const LAS f32x4*)(xs + (32 * qs + r32) * 8), x1 = *(const LAS f32x4*)(xs + (32 * qs + r32) * 8 + 4);
        const float tot = ((x0[0] + x0[1]) + (x0[2] + x0[3])) + ((x1[0] + x1[1]) + (x1[2] + x1[3]));
        const float rn = 1.f / sqrtf(tot * (1.f / 512.f) + LN_EPS);
        bf16_t* Op = O + (rowbase + q0 + 32 * qs + r32) * DM + (WIN ? 512 : 0) + head * 64 + 4 * hi;
        const float* gp = gainp + head * 64 + 4 * hi;
#pragma unroll
        for (int dh = 0; dh < 2; ++dh)
#pragma unroll
            for (int i = 0; i < 4; ++i) { const f32x4 g = *(const GAS f32x4*)(gp + 32 * dh + 8 * i);
                u32x2 w; w.x = pk2(o[qs][dh][4 * i] * rn * g[0], o[qs][dh][4 * i + 1] * rn * g[1]); w.y = pk2(o[qs][dh][4 * i + 2] * rn * g[2], o[qs][dh][4 * i + 3] * rn * g[3]);
                *(GAS u32x2*)(Op + 32 * dh + 8 * i) = w; }
    }
}
}

#define XB_TMO      128
#define XB_XCNT(j)  (256  + 64 * (j))
#define XB_XSUB(j)  (1280 + 64 * (j))
#define XB_XGEN(j)  (2304 + 64 * (j))
#define XB_TOP      3328
#define XB_TOPGEN   3392
#define XCD_BAR_WORDS 3456
#define XB_SPIN_CAP (1u << 18)

__device__ __forceinline__ unsigned xb_ld(unsigned* p)              { return __hip_atomic_load(p, __ATOMIC_RELAXED, __HIP_MEMORY_SCOPE_AGENT); }
__device__ __forceinline__ unsigned xb_add(unsigned* p, unsigned v) { return __hip_atomic_fetch_add(p, v, __ATOMIC_RELAXED, __HIP_MEMORY_SCOPE_AGENT); }
__device__ __forceinline__ unsigned xb_xcc_id() { return (unsigned)__builtin_amdgcn_s_getreg((3 << 11) | 20) & 0xFu; }
#define XB_SPIN(cond, bar) do { unsigned _sp = 0; while (cond) { __builtin_amdgcn_s_sleep(1); \
    if ((++_sp & 255u) == 0u) { if (xb_ld(&(bar)[XB_TMO])) break; if (_sp > XB_SPIN_CAP) { atomicAdd(&(bar)[XB_TMO], 1u); break; } } } } while (0)

struct XcdBarrier {
    unsigned* bar; unsigned x;
    volatile LAS unsigned* st;
};

__device__ __forceinline__ XcdBarrier xcd_barrier_post(unsigned* bar, volatile LAS unsigned* st) {
    XcdBarrier b; b.bar = bar; b.x = xb_xcc_id(); b.st = st;
    if (threadIdx.x == 0) (void)xb_add(&bar[XB_XCNT(b.x)], 1u);
    return b;
}
__device__ __forceinline__ void xcd_barrier_complete(unsigned* bar, unsigned x, unsigned& nloc, unsigned& nx) {
    const unsigned G = gridDim.x * gridDim.y * gridDim.z;
    unsigned sum, cnt, mine, sp = 0u;
    for (;;) {
        sum = 0u; cnt = 0u; mine = 0u;
#pragma unroll
        for (unsigned j = 0; j < 16; ++j) { const unsigned c = xb_ld(&bar[XB_XCNT(j)]); sum += c; cnt += (c > 0u) ? 1u : 0u; mine = (j == x) ? c : mine; }
        if (sum == G) break;
        __builtin_amdgcn_s_sleep(1);
        if ((++sp & 255u) == 0u) { if (xb_ld(&bar[XB_TMO])) break; if (sp > XB_SPIN_CAP) { atomicAdd(&bar[XB_TMO], 1u); break; } }
    }
    nloc = mine > 0u ? mine : 1u; nx = cnt > 0u ? cnt : 1u;
}

__device__ __forceinline__ void xcd_barrier(const XcdBarrier& b) {
    asm volatile("s_waitcnt vmcnt(0)" ::: "memory");
    __syncthreads();
    if (threadIdx.x == 0) {
        unsigned* bar = b.bar;
        __builtin_amdgcn_s_waitcnt(0);
        unsigned nloc = b.st[0], nx = b.st[1];
        if (nloc == 0u) { xcd_barrier_complete(bar, b.x, nloc, nx); b.st[0] = nloc; b.st[1] = nx; }
        const unsigned old = xb_add(&bar[XB_XSUB(b.x)], 1u);
        const unsigned gen = old / nloc;
        if (old + 1u == (gen + 1u) * nloc) {
            __builtin_amdgcn_fence(__ATOMIC_RELEASE, "agent");
            asm volatile("s_waitcnt vmcnt(0)" ::: "memory");
            const unsigned og = xb_add(&bar[XB_TOP], 1u);
            const unsigned tg = og / nx;
            if (og + 1u == (tg + 1u) * nx) xb_add(&bar[XB_TOPGEN], 1u);
            else XB_SPIN(xb_ld(&bar[XB_TOPGEN]) == tg, bar);
            __builtin_amdgcn_fence(__ATOMIC_ACQUIRE, "agent");
            xb_add(&bar[XB_XGEN(b.x)], 1u);
            asm volatile("s_waitcnt vmcnt(0)" ::: "memory");
        } else {
            XB_SPIN(xb_ld(&bar[XB_XGEN(b.x)]) == gen, bar);
            __builtin_amdgcn_fence(__ATOMIC_ACQUIRE, "agent");
            asm volatile("s_waitcnt vmcnt(0)" ::: "memory");
        }
    }
    __syncthreads();
}

__global__ void __launch_bounds__(NTHREADS, 2) fwd_megakernel(Params p) {
    extern __shared__ __attribute__((aligned(16))) unsigned char lds_raw[];
    LAS unsigned char* lds = (LAS unsigned char*)lds_raw;
    cg::grid_group grid = cg::this_grid();
    if (threadIdx.x < 64) ((LAS unsigned*)(lds + MISC_OFF))[threadIdx.x] = 0u;
    __syncthreads();
    (void)xcd_barrier_post((unsigned*)(p.ws + WS_BAR), (volatile LAS unsigned*)(lds + MISC_OFF));
    if (p.ph_lo == 0) {
        const int tid = threadIdx.x, lane = tid & 63, wave = __builtin_amdgcn_readfirstlane(tid >> 6);
        const int G = gridDim.x, bx = blockIdx.x;
        const int gw = bx * NWAVES + wave, NGW = G * NWAVES;
        const size_t gt = (size_t)bx * NTHREADS + tid, NT = (size_t)G * NTHREADS;
        unsigned char* ws = p.ws;
        float* cos1 = (float*)(ws + WS_TAB); float* sin1 = cos1 + 2048 * 32; float* cos2 = sin1 + 2048 * 32; float* sin2 = cos2 + 2048 * 32;
        bf16_t* X = (bf16_t*)(ws + WS_X);
        if (bx == 0 && tid == 0) { const float** tabw = (const float**)(ws + WS_PTAB);
#pragma unroll
            for (int i = 0; i < 24; ++i) tabw[i] = p.in[i];
            tabw[24] = (const float*)p.out; }
        if (PHM & 0x400) {
            for (size_t idx = gt; idx < 2048 * 32; idx += NT) {
                const int pos = (int)(idx >> 5), i = (int)(idx & 31);
                const float inv1 = exp2f(-(float)(2 * i) * (1.f / 64.f) * 13.287712379549449f);
                const double t1 = (double)pos * (double)inv1 * 0.15915494309189535;
                const float f1 = (float)(t1 - floor(t1));
                cos1[idx] = __builtin_amdgcn_cosf(f1); sin1[idx] = __builtin_amdgcn_sinf(f1);
                const int ii = i & 15, p2 = (i < 16) ? (pos >> 6) : (pos & 63);
                const float inv2 = exp2f(-(float)(2 * ii) * (1.f / 32.f) * 13.287712379549449f);
                const double t2 = (double)p2 * (double)inv2 * 0.15915494309189535;
                const float f2 = (float)(t2 - floor(t2));
                cos2[idx] = __builtin_amdgcn_cosf(f2); sin2[idx] = __builtin_amdgcn_sinf(f2);
            }
            convert_layer(p.in, ws, 0, lds, gw, NGW, wave, lane, gt, NT);
            for (int m = 4 * gw; m < MTOK; m += 4 * NGW) {
                const float* src = (m < MP) ? p.in[I_XP] + (size_t)m * DM : p.in[I_XS] + (size_t)(m - MP) * DM;
                ln_rows4(src, p.in[I_LN0G], p.in[I_LN0B], X + (size_t)m * DM, nullptr, lane);
            }
        }
        if (p.ph_hi > 1) grid.sync();
    }
    for (int gp = (p.ph_lo < 1 ? 1 : p.ph_lo); gp < p.ph_hi; ++gp) {
        unsigned char* ws_ = p.ws; asm volatile("" : "+s"(ws_));
        unsigned char* ws = as_global(ws_);
        int G_ = gridDim.x, bx_ = blockIdx.x; asm volatile("" : "+s"(G_), "+s"(bx_));
        const int G = G_, bx = bx_;
#define PHASE_IDS() int tid_ = threadIdx.x; asm volatile("" : "+v"(tid_)); const int tid = tid_, lane = tid & 63, wave = __builtin_amdgcn_readfirstlane(tid >> 6); \
        const int gw = bx * NWAVES + wave, NGW = G * NWAVES; const size_t gt = (size_t)bx * NTHREADS + tid, NT = (size_t)G * NTHREADS; (void)lane; (void)gw; (void)NGW; (void)gt; (void)NT;
        float* cos1 = (float*)(ws + WS_TAB); float* sin1 = cos1 + 2048 * 32; float* cos2 = sin1 + 2048 * 32; float* sin2 = cos2 + 2048 * 32;
        bf16_t* Wl = (bf16_t*)(ws + WS_W);
        bf16_t* Pb = (bf16_t*)(ws + WS_P);
        float* EG = (float*)(ws + WS_EDGE); float* EC = EG + EDGE_N; float* EV = EC + EDGE_N;
        bf16_t* X = (bf16_t*)(ws + WS_X); bf16_t* Hb = (bf16_t*)(ws + WS_H); bf16_t* Ob = (bf16_t*)(ws + WS_O); bf16_t* Vt = (bf16_t*)(ws + WS_VT);
        bf16_t* U = (bf16_t*)(ws + WS_U); bf16_t* Gb = (bf16_t*)(ws + WS_G);
        const UTab tab{(const float* const*)(ws + WS_PTAB)};
        float* Y = as_global(p.out);

        {
            const int rslot = p.rep_k <= 0 ? 0 : (p.rep_k == 2 ? 1 : p.rep_k - 2);
            const int nphl = p.rep_k >= 0 ? 9 : 8, l = (gp - 1) / nphl, slot = (gp - 1) % nphl, sl2 = (p.rep_k >= 0 && slot > rslot) ? slot - 1 : slot, k = sl2 == 0 ? 0 : (sl2 == 1 ? 2 : sl2 + 2);
            if (k == 0 && (PHM & 1)) {
                pg8::Gemm g{X, Wl + W_IN, MTOK, INW, DM}; pg8::StaticOrder S; S.init(MTOK, INW, G, bx);
                EpiQKV E{Hb, Vt, cos1, sin1, cos2, sin2, tab[I_QN] + l * 64, tab[I_KN] + l * 64, (LAS float*)(lds + XCH_OFF)};
                pg8::gemm_phase<EpiQKV, pg8::StaticOrder, true, true>(lds, g, S, E);
            } else if (k == 1 && (PHM & 2)) {
                PHASE_IDS();
                const int NT1 = (MTOK / 8) * 5;
                const float* qn = tab[I_QN] + l * 64; const float* kn = tab[I_KN] + l * 64;
                for (int t = gw; t < NT1; t += NGW) {
                    const int rb = t / 5, sg = t % 5;
                    const int row = rb * 8 + (lane >> 3), ch = lane & 7, pos = row & (SEQ - 1);
                    bf16_t* rowp = Hb + (size_t)row * INW + 8 * ch;
                    u32x4 w[4];
#pragma unroll
                    for (int i = 0; i < 4; ++i) { const int s = 4 * sg + i;
                        const int col = (s < 8) ? 64 * s : (s < 10) ? 512 + 64 * (s - 8) : (s < 18) ? 768 + 64 * (s - 10) : 1280 + 64 * (s - 18);
                        w[i] = *(const GAS u32x4*)(rowp + col); }
                    const f32x4 c2 = *(const GAS f32x4*)(cos2 + pos * 32 + 4 * ch), s2 = *(const GAS f32x4*)(sin2 + pos * 32 + 4 * ch);
                    const f32x4 c1 = *(const GAS f32x4*)(cos1 + pos * 32 + 4 * ch), s1 = *(const GAS f32x4*)(sin1 + pos * 32 + 4 * ch);
#pragma unroll
                    for (int i = 0; i < 4; ++i) { const int s = 4 * sg + i;
                        const bool ga = s < 10, isq = (s < 8) || (s >= 10 && s < 18);
                        const int col = (s < 8) ? 64 * s : (s < 10) ? 512 + 64 * (s - 8) : (s < 18) ? 768 + 64 * (s - 10) : 1280 + 64 * (s - 18);
                        f32x4 a, b; unpack8(w[i], a, b);
                        if (ga) {
                            float ss = (a[0] * a[0] + a[1] * a[1]) + (a[2] * a[2] + a[3] * a[3]) + (b[0] * b[0] + b[1] * b[1]) + (b[2] * b[2] + b[3] * b[3]);
                            ss += __shfl_xor(ss, 1); ss += __shfl_xor(ss, 2); ss += __shfl_xor(ss, 4);
                            const float rstd = 1.f / sqrtf(ss * (1.f / 64.f) + QK_EPS);
                            const float* gn = (s < 8 ? qn : kn) + 8 * ch;
                            const f32x4 g0 = *(const GAS f32x4*)gn, g1 = *(const GAS f32x4*)(gn + 4);
                            a = a * rstd * g0; b = b * rstd * g1;
                        }
                        const f32x4 c = ga ? c2 : c1, sn = ga ? s2 : s1;
                        f32x4 oa, ob;
                        oa[0] = a[0] * c[0] - a[1] * sn[0]; oa[1] = a[0] * sn[0] + a[1] * c[0];
                        oa[2] = a[2] * c[1] - a[3] * sn[1]; oa[3] = a[2] * sn[1] + a[3] * c[1];
                        ob[0] = b[0] * c[2] - b[1] * sn[2]; ob[1] = b[0] * sn[2] + b[1] * c[2];
                        ob[2] = b[2] * c[3] - b[3] * sn[3]; ob[3] = b[2] * sn[3] + b[3] * c[3];
                        if (isq) { oa = oa * QSCALE; ob = ob * QSCALE; }
                        *(GAS u32x4*)(rowp + col) = pack8(oa, ob);
                    }
                }
                LAS bf16_t* scr = (LAS bf16_t*)(lds + wave * 16384);
                const int NT2 = (MTOK / 64) * 4;
                for (int t = gw; t < NT2; t += NGW) {
                    const int tt = t >> 2, vs = t & 3, grp = vs >> 1, kh = vs & 1;
                    const int b = tt >> 5, s0 = (tt & 31) * 64;
                    const int col = (grp ? 1408 : 640) + 64 * kh;
                    const int ri = lane >> 3, ch = lane & 7;
#pragma unroll
                    for (int st = 0; st < 8; ++st) {
                        const int tok = ri + 8 * st;
                        const u32x4 w = *(const GAS u32x4*)(Hb + (size_t)(tt * 64 + tok) * INW + col + 8 * ch);
                        scr[(8 * ch + 0) * 72 + tok] = (bf16_t)(w.x & 0xffffu); scr[(8 * ch + 1) * 72 + tok] = (bf16_t)(w.x >> 16);
                        scr[(8 * ch + 2) * 72 + tok] = (bf16_t)(w.y & 0xffffu); scr[(8 * ch + 3) * 72 + tok] = (bf16_t)(w.y >> 16);
                        scr[(8 * ch + 4) * 72 + tok] = (bf16_t)(w.z & 0xffffu); scr[(8 * ch + 5) * 72 + tok] = (bf16_t)(w.z >> 16);
                        scr[(8 * ch + 6) * 72 + tok] = (bf16_t)(w.w & 0xffffu); scr[(8 * ch + 7) * 72 + tok] = (bf16_t)(w.w >> 16);
                    }
                    asm volatile("s_waitcnt lgkmcnt(0)" ::: "memory");
                    bf16_t* dst = Vt + ((size_t)((grp * NSEQ + b) * 2 + kh) * 64) * SEQ + s0;
#pragma unroll
                    for (int st = 0; st < 8; ++st) {
                        const int d = ri + 8 * st;
                        const u32x4 w = *(const LAS u32x4*)(scr + d * 72 + 8 * ch);
                        *(GAS u32x4*)(dst + (size_t)d * SEQ + 8 * ch) = w;
                    }
                    asm volatile("s_waitcnt lgkmcnt(0)" ::: "memory");
                }
            } else if (k == 2 && (PHM & 4)) {
                bool nomax;
                { int t_ = threadIdx.x; asm volatile("" : "+v"(t_)); const int ln = t_ & 63;
                  float gq = fabsf(*(const GAS float*)(tab[I_QN] + l * 64 + ln)), gk = fabsf(*(const GAS float*)(tab[I_KN] + l * 64 + ln));
#pragma unroll
                  for (int o_ = 1; o_ < 64; o_ <<= 1) { gq = fmaxf(gq, __shfl_xor(gq, o_)); gk = fmaxf(gk, __shfl_xor(gk, o_)); }
                  const float bound = 8.f * LOG2E * 1.02f * gq * gk;
                  nomax = __builtin_amdgcn_readfirstlane((int)(bound < 40.f)) != 0; }
                for (int i = 0;; ++i) {
                    const int u = i * G + bx; if (u >= 3072) break;
                    const bool win = u >= 1536; const int uu = win ? u - 1536 : u;
                    const int x = uu & 7, y = uu >> 3, qblk = y & 31, b = x + 8 * (y >> 5);
                    if (win) att::attn_unit<true>(lds, Hb, Vt, Ob, b, qblk, tab[I_SINK] + l * 8, tab[I_ONB] + l * 512, false);
                    else att::attn_unit<false>(lds, Hb, Vt, Ob, b, qblk, nullptr, tab[I_ONA] + l * 512, nomax);
                }
            } else if (k == 3 && (PHM & 8)) {
                PHASE_IDS();
                const float* gap = tab[I_ONA] + l * 512 + 8 * lane; const float* gbp = tab[I_ONB] + l * 512 + 8 * lane;
                const f32x4 ga0 = *(const GAS f32x4*)gap, ga1 = *(const GAS f32x4*)(gap + 4), gb0 = *(const GAS f32x4*)gbp, gb1 = *(const GAS f32x4*)(gbp + 4);
                for (int m = 4 * gw; m < MTOK; m += 4 * NGW) {
                    u32x4 wa[4], wb[4];
#pragma unroll
                    for (int r = 0; r < 4; ++r) { const bf16_t* orow = Ob + (size_t)(m + r) * DM; wa[r] = *(const GAS u32x4*)(orow + 8 * lane); wb[r] = *(const GAS u32x4*)(orow + 512 + 8 * lane); }
                    f32x4 a0[4], a1[4], b0[4], b1[4]; float sa[4], sb[4];
#pragma unroll
                    for (int r = 0; r < 4; ++r) { unpack8(wa[r], a0[r], a1[r]); unpack8(wb[r], b0[r], b1[r]);
                        sa[r] = (a0[r][0] * a0[r][0] + a0[r][1] * a0[r][1]) + (a0[r][2] * a0[r][2] + a0[r][3] * a0[r][3]) + (a1[r][0] * a1[r][0] + a1[r][1] * a1[r][1]) + (a1[r][2] * a1[r][2] + a1[r][3] * a1[r][3]);
                        sb[r] = (b0[r][0] * b0[r][0] + b0[r][1] * b0[r][1]) + (b0[r][2] * b0[r][2] + b0[r][3] * b0[r][3]) + (b1[r][0] * b1[r][0] + b1[r][1] * b1[r][1]) + (b1[r][2] * b1[r][2] + b1[r][3] * b1[r][3]); }
#pragma unroll
                    for (int o = 1; o < 64; o <<= 1)
#pragma unroll
                        for (int r = 0; r < 4; ++r) { sa[r] += __shfl_xor(sa[r], o); sb[r] += __shfl_xor(sb[r], o); }
#pragma unroll
                    for (int r = 0; r < 4; ++r) {
                        const float ra = 1.f / sqrtf(sa[r] * (1.f / 512.f) + LN_EPS), rb = 1.f / sqrtf(sb[r] * (1.f / 512.f) + LN_EPS);
                        bf16_t* orow = Ob + (size_t)(m + r) * DM;
                        *(GAS u32x4*)(orow + 8 * lane) = pack8(a0[r] * ra * ga0, a1[r] * ra * ga1); *(GAS u32x4*)(orow + 512 + 8 * lane) = pack8(b0[r] * rb * gb0, b1[r] * rb * gb1);
                    }
                }
            } else if (k == 4 && (PHM & 16)) {
                pg8::Gemm g{Ob, Wl + W_OUT, MTOK, DM, DM}; pg8::StaticOrder S; S.init(MTOK, DM, G, bx);
                EpiRes<false> E{X, nullptr, Y, (bf16_t*)Y, false, l > 0, (const float*)(ws + WS_ST), tab[I_LN2G] + (l > 0 ? l - 1 : 0) * DM, tab[I_LN2B] + (l > 0 ? l - 1 : 0) * DM, (bf16_t*)Y};
                pg8::gemm_phase<EpiRes<false>, pg8::StaticOrder, true, true>(lds, g, S, E);
            } else if (k == 5 && (PHM & 32)) {
                PHASE_IDS();
                { const float* lg = tab[I_LN1G] + l * DM; const float* lb = tab[I_LN1B] + l * DM;
                  for (int m = 4 * gw; m < MTOK; m += 4 * NGW) ln_rows4_bf16((const bf16_t*)Y + (size_t)m * DM, lg, lb, X + (size_t)m * DM, (float*)(ws + WS_ST) + 2 * (size_t)m, lane); }
            } else if (k == 6 && (PHM & 64)) {
                pg8::Gemm g{X, Wl + W_UP, MTOK, 2 * DFF, DM}; pg8::StaticOrder S; S.init(MTOK, 2 * DFF, G, bx);
                EpiUp E{U, EG, EC, EV, tab[I_CW] + (size_t)l * 3 * DFF, tab[I_CB] + (size_t)l * DFF, (LAS float*)(lds + XCH_OFF)};
                pg8::gemm_phase<EpiUp, pg8::StaticOrder, true, true>(lds, g, S, E);
            } else if (k == 7 && (PHM & 128)) {
                PHASE_IDS();
                const float* cw = tab[I_CW] + (size_t)l * 3 * DFF;
                const size_t NF = (size_t)(MTOK / 256) * 2 * (DFF / 4);
                for (size_t i = gt; i < NF; i += NT) {
                    const int c4 = (int)(i % (DFF / 4)), pe = (int)(i / (DFF / 4)), pm = pe >> 1, e = pe & 1, ch = 4 * c4;
                    const int r0 = pm * 256;
                    if (e == 0) {
                        if ((r0 & (SEQ - 1)) == 0) continue;
                        const size_t me = ((size_t)pm * 2 + 0) * DFF + ch, ne = ((size_t)(pm - 1) * 2 + 1) * DFF + ch;
                        const f32x4 c = *(const GAS f32x4*)(EC + me) + *(const GAS f32x4*)(cw + ch) * *(const GAS f32x4*)(EG + ne); const f32x4 v = *(const GAS f32x4*)(EV + me);
                        u32x2 w; w.x = pk2(gelu_tanh(c[0]) * v[0], gelu_tanh(c[1]) * v[1]); w.y = pk2(gelu_tanh(c[2]) * v[2], gelu_tanh(c[3]) * v[3]);
                        *(GAS u32x2*)(U + (size_t)r0 * DFF + ch) = w;
                    } else {
                        if (((r0 + 256) & (SEQ - 1)) == 0) continue;
                        const size_t me = ((size_t)pm * 2 + 1) * DFF + ch, ne = ((size_t)(pm + 1) * 2 + 0) * DFF + ch;
                        const f32x4 c = *(const GAS f32x4*)(EC + me) + *(const GAS f32x4*)(cw + 2 * DFF + ch) * *(const GAS f32x4*)(EG + ne); const f32x4 v = *(const GAS f32x4*)(EV + me);
                        u32x2 w; w.x = pk2(gelu_tanh(c[0]) * v[0], gelu_tanh(c[1]) * v[1]); w.y = pk2(gelu_tanh(c[2]) * v[2], gelu_tanh(c[3]) * v[3]);
                        *(GAS u32x2*)(U + (size_t)(r0 + 255) * DFF + ch) = w;
                    }
                }
                { pg8::Gemm g{X, Wl + W_GATE, MTOK, DM, DM}; pg8::StaticOrder S; S.init(MTOK, DM, G, bx);
                  EpiGate E{Gb, tab[I_BGATE] + (size_t)l * DM};
                  pg8::gemm_phase<EpiGate, pg8::StaticOrder, true, true>(lds, g, S, E); }
                { pg8::Gemm g{Pb, Wl + W_PLE, MTOK, DM, DPLE}; pg8::StaticOrder S; S.init(MTOK, DM, G, bx);
                  EpiPle E{Gb};
                  pg8::gemm_phase<EpiPle, pg8::StaticOrder, true, true>(lds, g, S, E); }
            } else if (k == 8 && (PHM & 256)) {
                pg8::Gemm g{U, Wl + W_DOWN, MTOK, DM, DFF}; pg8::StaticOrder S; S.init(MTOK, DM, G, bx);
                EpiRes<true> E{X, Gb, Y, (bf16_t*)Y, false, true, (const float*)(ws + WS_ST), tab[I_LN1G] + l * DM, tab[I_LN1B] + l * DM, (l == DEPTH - 1) ? X : (bf16_t*)Y};
                pg8::gemm_phase<EpiRes<true>, pg8::StaticOrder, true, true>(lds, g, S, E);
            } else if (PHM & 0x200) {
                PHASE_IDS();
                const bool lastl = (l == DEPTH - 1);
                { const float* lg = tab[I_LN2G] + l * DM; const float* lb = tab[I_LN2B] + l * DM;
                  if (lastl) { for (int m = 4 * gw; m < MTOK; m += 4 * NGW) ln_rows4_bf16(X + (size_t)m * DM, lg, lb, nullptr, nullptr, lane, Y + (size_t)m * DM); }
                  else { for (int m = 4 * gw; m < MTOK; m += 4 * NGW) ln_rows4_bf16((const bf16_t*)Y + (size_t)m * DM, lg, lb, X + (size_t)m * DM, (float*)(ws + WS_ST) + 2 * (size_t)m, lane); } }
                if (!lastl) convert_layer(tab, ws, l + 1, lds, gw, NGW, wave, lane, gt, NT);
            }
        }
        if (gp + 1 < p.ph_hi) { XcdBarrier xb; xb.bar = (unsigned*)(ws + WS_BAR); xb.x = xb_xcc_id(); xb.st = (volatile LAS unsigned*)(lds + MISC_OFF); xcd_barrier(xb); }
    }
}

extern "C" void kernel_launch(void* const* d_in, const int* in_sizes, int n_in, void* d_out, int out_size, void* d_ws, size_t ws_size, hipStream_t stream) {
    static int grid = 0;
    if (grid == 0) {
        if (n_in != 24 || out_size != MTOK * DM || ws_size < WS_NEED) { fprintf(stderr, "kernel_launch: unexpected shapes (n_in %d, out %d, ws %zu, need %zu)\n", n_in, out_size, ws_size, (size_t)WS_NEED); grid = -1; return; }
        int dev = 0, cus = 0, per_cu = 0;
        hipGetDevice(&dev);
        hipDeviceGetAttribute(&cus, hipDeviceAttributeMultiprocessorCount, dev);
        if (hipFuncSetAttribute((const void*)fwd_megakernel, hipFuncAttributeMaxDynamicSharedMemorySize, LDS_BYTES) != hipSuccess) { fprintf(stderr, "kernel_launch: hipFuncSetAttribute failed\n"); grid = -1; return; }
        if (hipOccupancyMaxActiveBlocksPerMultiprocessor(&per_cu, (const void*)fwd_megakernel, NTHREADS, LDS_BYTES) != hipSuccess || per_cu < 1) { fprintf(stderr, "kernel_launch: occupancy query says %d\n", per_cu); (void)hipGetLastError(); per_cu = 1; }
        grid = cus * per_cu;
        fprintf(stderr, "kernel_launch: grid %d (cus %d x %d)\n", grid, cus, per_cu);
    }
    if (grid < 0) return;
    if (hipMemsetAsync((char*)d_ws + WS_BAR, 0, 16384, stream) != hipSuccess) { fprintf(stderr, "kernel_launch: memset failed\n"); return; }
    Params p{};
    for (int i = 0; i < 24; ++i) p.in[i] = (const float*)d_in[i];
    p.out = (float*)d_out; p.ws = (unsigned char*)d_ws;
#if MK_PER_PHASE_LAUNCH
    for (int ph = 0; ph < NPHASES; ++ph) {
        p.ph_lo = ph; p.ph_hi = ph + 1;
        void* args[] = {&p};
        hipError_t e = hipLaunchCooperativeKernel((const void*)fwd_megakernel, dim3(grid), dim3(NTHREADS), args, LDS_BYTES, stream);
        if (e != hipSuccess) { fprintf(stderr, "launch %d failed: %s\n", ph, hipGetErrorString(e)); break; }
    }
#else
    p.rep_k = REP_K; p.ph_lo = 0; p.ph_hi = 1 + (REP_K >= 0 ? 9 : 8) * DEPTH;
    void* args[] = {&p};
    hipError_t e = hipLaunchCooperativeKernel((const void*)fwd_megakernel, dim3(grid), dim3(NTHREADS), args, LDS_BYTES, stream);
    if (e != hipSuccess) fprintf(stderr, "cooperative launch failed: %s (grid %d)\n", hipGetErrorString(e), grid);
#endif
}
```

```cpp
#include <hip/hip_runtime.h>
#include <hip/hip_cooperative_groups.h>
#include <cstdio>
#include <cstdint>
namespace cg = cooperative_groups;
namespace pg8 {
#define PG8_LAS __attribute__((address_space(3)))
typedef unsigned short bf16_t;
typedef short bf16x8 __attribute__((ext_vector_type(8)));
typedef float f32x4 __attribute__((ext_vector_type(4)));
typedef unsigned u32x4 __attribute__((ext_vector_type(4)));
constexpr int BM = 256, BK = 64, HALF = 128, HTB = HALF * BK * 2  , STAGE_BYTES = 8 * HTB, NXCD = 8, WGM = 8;

__host__ __device__ __forceinline__ int lds_byte(int r, int c) { const int st = (r >> 4) * 2 + (c >> 5), rr = r & 15, cc = c & 31, ob = rr * 64 + cc * 2; return st * 1024 + (ob ^ (((ob >> 9) & 1) << 5)); }
__host__ __device__ __forceinline__ void stage_rc(int b, int& R, int& C) { const int st = b / 1024, sb = b % 1024, swz = sb ^ (((sb >> 9) & 1) << 5); R = (st >> 1) * 16 + swz / 64; C = (st & 1) * 32 + (swz % 64) / 2; }
__host__ __device__ __forceinline__ int perm32(int rho) { const int n = rho >> 4, i = rho & 15; return 8 * (i >> 2) + 4 * n + (i & 3); }

struct Unit { int pm, pn; };
struct Gemm { const bf16_t* A; const bf16_t* Bt; int M, N, K; };

struct StaticOrder {
    int nM, nN, nwg, G, c;
    __host__ __device__ void init(int M, int N, int G_, int c_) { nM = M / BM; nN = N / BM; nwg = nM * nN; G = G_; c = c_; }
    __host__ __device__ bool next(int i, Unit& u) const {
        const long L = (long)i * G + c; if (L >= nwg) return false;
        int wgid = (int)L; { const int q = nwg / NXCD, r = nwg % NXCD, xcd = wgid % NXCD, off = wgid / NXCD; wgid = (xcd < r ? xcd * (q + 1) : r * (q + 1) + (xcd - r) * q) + off; }
        const int nig = WGM * nN, gid = wgid / nig, fm = gid * WGM, gsz = (nM - fm) < WGM ? (nM - fm) : WGM;
        u.pm = fm + ((wgid % nig) % gsz); u.pn = (wgid % nig) / gsz; return true;
    }
    __device__ __forceinline__ void a_ready(const Unit&) const {}
    __device__ __forceinline__ void done(const Unit&) const {}
};

__device__ __forceinline__ unsigned cvt_pk_bf16(float lo, float hi) { unsigned r; asm volatile("v_cvt_pk_bf16_f32 %0, %1, %2" : "=v"(r) : "v"(lo), "v"(hi)); return r; }
template <class Epi, class Sched, bool ALIGN_EPI = false, bool SP2 = false>
__device__ __forceinline__ void gemm_phase(PG8_LAS unsigned char* lds, const Gemm g, const Sched& S, const Epi& E) {
    int tid_ = threadIdx.x; asm volatile("" : "+v"(tid_));
    const int tid = tid_, wid = __builtin_amdgcn_readfirstlane(tid >> 6), lane = tid & 63, wr = wid >> 2, wc = wid & 3, fr = lane & 15, fq = lane >> 4;
    const int K = g.K, nt = K / BK;
    unsigned voffA[2], voffB[2];
#pragma unroll
    for (int i = 0; i < 2; ++i) { int R, C; stage_rc(tid * 16 + i * 8192, R, C); const int Rb = Epi::PERM ? ((R & ~31) + perm32(R & 31)) : R;
        voffA[i] = (unsigned)(R * K + C) * 2u; voffB[i] = (unsigned)(Rb * K + C) * 2u; }
    const size_t kstep = (size_t)(BK * 2);
    const size_t hstep = (size_t)HALF * K * 2;
    const size_t tstep = 2 * hstep;
    const unsigned ldsw = (unsigned)wid * 1024u;
    const int aoff = lds_byte(wr * 64 + fr, fq * 8), boff = lds_byte(wc * 32 + fr, fq * 8);
#define PG8_SA(b, h) (((b) * 2 + (h)) * HTB)
#define PG8_SB(b, h) ((4 + (b) * 2 + (h)) * HTB)
#define PG8_STAGE(bufoff, gbase, voff) do { _Pragma("unroll") for (int _i = 0; _i < 2; ++_i) \
        __builtin_amdgcn_global_load_lds((const unsigned*)((const char*)(gbase) + (voff)[_i]), (PG8_LAS unsigned*)(lds + (bufoff) + ldsw + _i * 8192), 16, 0, 0); } while (0)
#define PG8_LDA(dst, b, h) do { _Pragma("unroll") for (int m = 0; m < 4; ++m) _Pragma("unroll") for (int k = 0; k < 2; ++k) dst[m][k] = *(const PG8_LAS bf16x8*)(lds + PG8_SA(b, h) + aoff + m * 2048 + k * 1024); } while (0)
#define PG8_LDB(dst, b, h) do { _Pragma("unroll") for (int n = 0; n < 2; ++n) _Pragma("unroll") for (int k = 0; k < 2; ++k) dst[n][k] = *(const PG8_LAS bf16x8*)(lds + PG8_SB(b, h) + boff + n * 2048 + k * 1024); } while (0)
#define PG8_MMA(ai, bj, At, Bt) do { __builtin_amdgcn_s_setprio(1); _Pragma("unroll") for (int m = 0; m < 4; ++m) _Pragma("unroll") for (int n = 0; n < 2; ++n) _Pragma("unroll") for (int k = 0; k < 2; ++k) \
        acc[ai][bj][m][n] = __builtin_amdgcn_mfma_f32_16x16x32_bf16(Bt[n][k], At[m][k], acc[ai][bj][m][n], 0, 0, 0); __builtin_amdgcn_s_setprio(0); } while (0)
#define PG8_WAIT_V(n) asm volatile("s_waitcnt vmcnt(" #n ")" ::: "memory")
#define PG8_WAIT_L(n) asm volatile("s_waitcnt lgkmcnt(" #n ")" ::: "memory")
#define PG8_BAR __builtin_amdgcn_s_barrier()
#define PG8_SCHED __builtin_amdgcn_sched_barrier(0)
    Unit cur, nxt; int ui = 0;
    if (!S.next(0, cur)) return;
    f32x4 acc[2][2][4][2];
#pragma unroll
    for (int a = 0; a < 2; ++a)
#pragma unroll
        for (int b = 0; b < 2; ++b)
#pragma unroll
            for (int m = 0; m < 4; ++m)
#pragma unroll
                for (int n = 0; n < 2; ++n) acc[a][b][m][n] = (f32x4){0.f, 0.f, 0.f, 0.f};
    bf16x8 At[4][2], B0[2][2], B1[2][2];
    const char* cA = (const char*)g.A + (size_t)cur.pm * tstep; const char* cB = (const char*)g.Bt + (size_t)cur.pn * tstep;
    S.a_ready(cur);
    if constexpr (SP2) {
        PG8_STAGE(PG8_SB(0, 0), cB, voffB); PG8_STAGE(PG8_SB(0, 1), cB + hstep, voffB); PG8_STAGE(PG8_SA(0, 0), cA, voffA); PG8_STAGE(PG8_SA(0, 1), cA + hstep, voffA);
        if (wr == 1) PG8_BAR;
        PG8_WAIT_V(2); PG8_BAR;
        PG8_STAGE(PG8_SB(1, 0), cB + kstep, voffB); PG8_STAGE(PG8_SA(1, 0), cA + kstep, voffA); PG8_STAGE(PG8_SB(1, 1), cB + hstep + kstep, voffB);
        PG8_WAIT_V(6); PG8_BAR;
    } else {
        PG8_STAGE(PG8_SB(0, 0), cB, voffB); PG8_STAGE(PG8_SA(0, 0), cA, voffA); PG8_STAGE(PG8_SB(0, 1), cB + hstep, voffB); PG8_STAGE(PG8_SA(0, 1), cA + hstep, voffA);
        if (wr == 1) PG8_BAR;
        PG8_WAIT_V(4); PG8_BAR;
        PG8_STAGE(PG8_SB(1, 0), cB + kstep, voffB); PG8_STAGE(PG8_SA(1, 0), cA + kstep, voffA); PG8_STAGE(PG8_SB(1, 1), cB + hstep + kstep, voffB);
        PG8_WAIT_V(6); PG8_BAR;
    }
    for (;;) {
        const bool has_next = S.next(ui + 1, nxt);
        const char* nA = has_next ? (const char*)g.A + (size_t)nxt.pm * tstep : cA; const char* nB = has_next ? (const char*)g.Bt + (size_t)nxt.pn * tstep : cB;
        for (int t = 0; t < nt; t += 2) {
            const bool last = (t == nt - 2);
            const char* a1 = cA + (size_t)(t + 1) * kstep;
            const char* a2 = last ? nA : cA + (size_t)(t + 2) * kstep; const char* b2 = last ? nB : cB + (size_t)(t + 2) * kstep;
            const char* a3 = a2 + kstep; const char* b3 = b2 + kstep;
            if (last && has_next) S.a_ready(nxt);
            if constexpr (SP2) {
            PG8_LDB(B0, 0, 0); PG8_LDB(B1, 0, 1); PG8_SCHED; PG8_LDA(At, 0, 0); PG8_STAGE(PG8_SA(1, 1), a1 + hstep, voffA);
            PG8_WAIT_V(8); PG8_WAIT_L(0); PG8_BAR; PG8_MMA(0, 0, At, B0); PG8_MMA(0, 1, At, B1); PG8_BAR; PG8_SCHED;
            PG8_LDA(At, 0, 1); PG8_STAGE(PG8_SB(0, 0), b2, voffB); PG8_STAGE(PG8_SB(0, 1), b2 + hstep, voffB); PG8_STAGE(PG8_SA(0, 0), a2, voffA);
            PG8_WAIT_V(8); PG8_WAIT_L(0); PG8_BAR; PG8_MMA(1, 0, At, B0); PG8_MMA(1, 1, At, B1); PG8_BAR; PG8_SCHED;
            PG8_LDB(B0, 1, 0); PG8_LDB(B1, 1, 1); PG8_SCHED; PG8_LDA(At, 1, 0); PG8_STAGE(PG8_SA(0, 1), a2 + hstep, voffA);
            PG8_WAIT_V(8); PG8_WAIT_L(0); PG8_BAR; PG8_MMA(0, 0, At, B0); PG8_MMA(0, 1, At, B1); PG8_BAR; PG8_SCHED;
            PG8_LDA(At, 1, 1); PG8_STAGE(PG8_SB(1, 0), b3, voffB); PG8_STAGE(PG8_SB(1, 1), b3 + hstep, voffB); PG8_STAGE(PG8_SA(1, 0), a3, voffA);
            PG8_WAIT_V(8); PG8_WAIT_L(0); PG8_BAR; PG8_MMA(1, 0, At, B0); PG8_MMA(1, 1, At, B1); PG8_BAR; PG8_SCHED;
            } else {
            PG8_LDB(B0, 0, 0); PG8_SCHED; PG8_LDA(At, 0, 0); PG8_STAGE(PG8_SA(1, 1), a1 + hstep, voffA);
            PG8_WAIT_L(8); PG8_BAR; PG8_WAIT_L(0); PG8_MMA(0, 0, At, B0); PG8_BAR; PG8_SCHED;
            PG8_LDB(B1, 0, 1); PG8_STAGE(PG8_SB(0, 0), b2, voffB);
            PG8_BAR; PG8_WAIT_L(0); PG8_MMA(0, 1, At, B1); PG8_BAR;
            PG8_LDA(At, 0, 1); PG8_STAGE(PG8_SA(0, 0), a2, voffA);
            PG8_BAR; PG8_WAIT_L(0); PG8_MMA(1, 0, At, B0); PG8_BAR; PG8_SCHED;
            PG8_STAGE(PG8_SB(0, 1), b2 + hstep, voffB);
            PG8_WAIT_V(6); PG8_BAR; PG8_MMA(1, 1, At, B1); PG8_BAR;
            PG8_LDB(B0, 1, 0); PG8_SCHED; PG8_LDA(At, 1, 0); PG8_STAGE(PG8_SA(0, 1), a2 + hstep, voffA);
            PG8_WAIT_L(8); PG8_BAR; PG8_WAIT_L(0); PG8_MMA(0, 0, At, B0); PG8_BAR; PG8_SCHED;
            PG8_LDB(B1, 1, 1); PG8_STAGE(PG8_SB(1, 0), b3, voffB);
            PG8_BAR; PG8_WAIT_L(0); PG8_MMA(0, 1, At, B1); PG8_BAR;
            PG8_LDA(At, 1, 1); PG8_STAGE(PG8_SA(1, 0), a3, voffA);
            PG8_BAR; PG8_WAIT_L(0); PG8_MMA(1, 0, At, B0); PG8_BAR; PG8_SCHED;
            PG8_STAGE(PG8_SB(1, 1), b3 + hstep, voffB);
            PG8_WAIT_V(6); PG8_BAR; PG8_MMA(1, 1, At, B1); PG8_BAR;
            }
        }
        if constexpr (ALIGN_EPI) { if (wr == 0) PG8_BAR; }
        if constexpr (!Epi::AFTER_DRAIN) { E(acc, cur, wr, wc, fr, fq); S.done(cur); }
        if (!has_next) break;
#pragma unroll
        for (int a = 0; a < 2; ++a)
#pragma unroll
            for (int b = 0; b < 2; ++b)
#pragma unroll
                for (int m = 0; m < 4; ++m)
#pragma unroll
                    for (int n = 0; n < 2; ++n) acc[a][b][m][n] = (f32x4){0.f, 0.f, 0.f, 0.f};
        cur = nxt; cA = nA; cB = nB; ++ui;
        if constexpr (ALIGN_EPI) { if (wr == 1) PG8_BAR; }
    }
    PG8_WAIT_V(0);
    if constexpr (!ALIGN_EPI) { if (wr == 0) PG8_BAR; }
    PG8_BAR;
    if constexpr (Epi::AFTER_DRAIN) { E.fused(acc, cur, wr, wc, fr, fq, lds, wid, lane); S.done(cur); }
#undef PG8_SA
#undef PG8_SB
#undef PG8_STAGE
#undef PG8_LDA
#undef PG8_LDB
#undef PG8_MMA
#undef PG8_WAIT_V
#undef PG8_WAIT_L
#undef PG8_BAR
#undef PG8_SCHED
}
}

#ifndef REP_K
#define REP_K -1
#endif
#ifndef PHM
#define PHM 0xFFF5
#endif
#ifndef MK_PER_PHASE_LAUNCH
#define MK_PER_PHASE_LAUNCH 0
#endif
#define LAS __attribute__((address_space(3)))
#define GAS __attribute__((address_space(1)))
typedef unsigned short bf16_t;
typedef float f32x4 __attribute__((ext_vector_type(4)));
typedef unsigned u32x4 __attribute__((ext_vector_type(4)));
typedef unsigned u32x2 __attribute__((ext_vector_type(2)));
typedef short bf16x8 __attribute__((ext_vector_type(8)));
typedef float f32x16 __attribute__((ext_vector_type(16)));
typedef float f32x2_t __attribute__((ext_vector_type(2)));
typedef __bf16 bf16x2_t __attribute__((ext_vector_type(2)));

constexpr int DM = 1024, SEQ = 2048, NSEQ = 48, NSEQ_P = 16, MTOK = NSEQ * SEQ, MP = NSEQ_P * SEQ;
constexpr int DEPTH = 4, INW = 1536, DFF = 2816, DPLE = 256;
constexpr float ALPHA = 1.6817928305074290f;
constexpr float LN_EPS = 1e-5f, QK_EPS = 1e-6f;
constexpr float LOG2E = 1.4426950408889634f;
constexpr float QSCALE = 0.125f * LOG2E;
constexpr int NTHREADS = 512, NWAVES = 8;
constexpr int NPHASES = 1 + 8 * DEPTH;

constexpr size_t MiB = (size_t)1 << 20;
constexpr size_t WS_TAB = 0;
constexpr size_t WS_BAR = 98 * MiB;
constexpr size_t WS_PTAB = 99 * MiB;
constexpr size_t WS_W = 1 * MiB;
constexpr size_t W_IN = 0, W_OUT = W_IN + (size_t)INW * DM, W_UP = W_OUT + (size_t)DM * DM, W_DOWN = W_UP + (size_t)2 * DFF * DM,
                 W_PLE = W_DOWN + (size_t)DM * DFF, W_GATE = W_PLE + (size_t)DM * DPLE, W_END = W_GATE + (size_t)DM * DM;
static_assert(W_END * 2 <= 24 * MiB, "weights region");
constexpr size_t WS_P = 25 * MiB;
constexpr size_t WS_EDGE = 73 * MiB;
constexpr size_t EDGE_N = (size_t)(MTOK / 256) * 2 * DFF;
static_assert(WS_EDGE + 3 * EDGE_N * 4 <= 100 * MiB, "edge region");
constexpr size_t WS_X = 100 * MiB;
constexpr size_t WS_H = 292 * MiB;
constexpr size_t WS_O = 580 * MiB;
constexpr size_t WS_VT = 772 * MiB;
constexpr size_t WS_U = 292 * MiB;
constexpr size_t WS_G = 820 * MiB;
constexpr size_t WS_ST = 1012 * MiB;
constexpr size_t WS_NEED = 1013 * MiB;

constexpr int RING_BYTES = 131072, XCH_OFF = RING_BYTES, MISC_OFF = RING_BYTES + 16384 + 2048, LDS_BYTES = MISC_OFF + 256;

struct Params { const float* in[24]; float* out; unsigned char* ws; int ph_lo, ph_hi, rep_k, pad; };
enum { I_XP = 0, I_XS, I_PP, I_PS, I_LN0G, I_LN0B, I_WIN, I_QN, I_KN, I_SINK, I_ONA, I_ONB, I_WOUT, I_LN1G, I_LN1B, I_WUP, I_CW, I_CB, I_WDOWN, I_LN2G, I_LN2B, I_WPLE, I_WGATE, I_BGATE };

template <class T> __device__ __forceinline__ T* as_global(T* p) { return (T*)(GAS T*)p; }
struct UTab { const float* const* t;
    __device__ __forceinline__ const float* operator[](int i) const { const unsigned long long v = (unsigned long long)as_global(t)[i];
        const unsigned lo = __builtin_amdgcn_readfirstlane((unsigned)v), hi = __builtin_amdgcn_readfirstlane((unsigned)(v >> 32)); return as_global((const float*)(((unsigned long long)hi << 32) | lo)); } };
__device__ __forceinline__ unsigned pk2(float lo, float hi) { f32x2_t v = {lo, hi}; bf16x2_t b = __builtin_convertvector(v, bf16x2_t); return __builtin_bit_cast(unsigned, b); }
__device__ __forceinline__ u32x4 pack8(f32x4 a, f32x4 b) { u32x4 w; w.x = pk2(a[0], a[1]); w.y = pk2(a[2], a[3]); w.z = pk2(b[0], b[1]); w.w = pk2(b[2], b[3]); return w; }
__device__ __forceinline__ float bflo(unsigned u) { return __uint_as_float(u << 16); }
__device__ __forceinline__ float bfhi(unsigned u) { return __uint_as_float(u & 0xffff0000u); }
__device__ __forceinline__ void unpack8(u32x4 w, f32x4& a, f32x4& b) { a[0] = bflo(w.x); a[1] = bfhi(w.x); a[2] = bflo(w.y); a[3] = bfhi(w.y); b[0] = bflo(w.z); b[1] = bfhi(w.z); b[2] = bflo(w.w); b[3] = bfhi(w.w); }
__device__ __forceinline__ float wave_sum(float v) {
#pragma unroll
    for (int o = 1; o < 64; o <<= 1) v += __shfl_xor(v, o);
    return v;
}
__device__ __forceinline__ float fast_exp2(float x) { return __builtin_amdgcn_exp2f(x); }
__device__ __forceinline__ float fast_rcp(float x) { return __builtin_amdgcn_rcpf(x); }
__device__ __forceinline__ float gelu_tanh(float c) {
    const float z = c + 0.044715f * c * c * c;
    return c * fast_rcp(1.0f + fast_exp2(-2.3022082f * z));
}
__device__ __forceinline__ float sigmoidf_(float t) { return fast_rcp(1.0f + fast_exp2(-LOG2E * t)); }

__device__ __forceinline__ float dpp_shr1(float v) { return __int_as_float(__builtin_amdgcn_update_dpp(__float_as_int(v), __float_as_int(v), 0x111, 0xf, 0xf, false)); }
__device__ __forceinline__ float dpp_shl1(float v) { return __int_as_float(__builtin_amdgcn_update_dpp(__float_as_int(v), __float_as_int(v), 0x101, 0xf, 0xf, false)); }
struct EpiH {
    static constexpr bool PERM = true, AFTER_DRAIN = false;
    bf16_t* O; int ldc;
    __device__ __forceinline__ void operator()(const f32x4 (&acc)[2][2][4][2], const pg8::Unit& u, int wr, int wc, int fr, int fq) const {
        { int t_ = threadIdx.x; asm volatile("" : "+v"(t_)); fr = t_ & 15; fq = (t_ >> 4) & 3; }
        const int row0 = u.pm * 256 + wr * 64 + fr, col0 = u.pn * 256 + wc * 32 + 8 * fq;
#pragma unroll
        for (int ai = 0; ai < 2; ++ai)
#pragma unroll
            for (int m = 0; m < 4; ++m) { bf16_t* rowp = O + (size_t)(row0 + ai * 128 + m * 16) * ldc + col0;
#pragma unroll
                for (int bj = 0; bj < 2; ++bj) *(GAS u32x4*)(rowp + bj * 128) = pack8(acc[ai][bj][m][0], acc[ai][bj][m][1]); }
    }
};
struct EpiQKV {
    static constexpr bool PERM = true, AFTER_DRAIN = false;
    bf16_t* H; bf16_t* Vt; const float* cos1; const float* sin1; const float* cos2; const float* sin2; const float* qn; const float* kn; LAS float* xch;
    __device__ __forceinline__ void operator()(const f32x4 (&acc)[2][2][4][2], const pg8::Unit& u, int wr, int wc, int fr, int fq) const {
        { int t_ = threadIdx.x; asm volatile("" : "+v"(t_)); fr = t_ & 15; fq = (t_ >> 4) & 3; }
        const int pn = u.pn; const bool grpA = pn < 3, hasV = (pn == 2 || pn == 5), isq = !hasV;
        const int rl0 = wr * 64 + fr;
        if (grpA) {
#pragma unroll
            for (int ai = 0; ai < 2; ++ai)
#pragma unroll
                for (int m = 0; m < 4; ++m)
#pragma unroll
                    for (int bj = 0; bj < 2; ++bj) {
                        const f32x4 a = acc[ai][bj][m][0], b = acc[ai][bj][m][1];
                        float ss = (a[0] * a[0] + a[1] * a[1]) + (a[2] * a[2] + a[3] * a[3]) + (b[0] * b[0] + b[1] * b[1]) + (b[2] * b[2] + b[3] * b[3]);
                        ss += __shfl_xor(ss, 16); ss += __shfl_xor(ss, 32);
                        if (fq == 0) xch[((rl0 + ai * 128 + m * 16) * 2 + bj) * 4 + wc] = ss;
                    }
            asm volatile("s_waitcnt lgkmcnt(0)" ::: "memory"); __builtin_amdgcn_s_barrier(); asm volatile("" ::: "memory");
        }
        const int dbase = 32 * (wc & 1) + 8 * fq, i0 = 16 * (wc & 1) + 4 * fq, col0 = pn * 256 + wc * 32 + 8 * fq;
        const float* ctab = grpA ? cos2 : cos1; const float* stab = grpA ? sin2 : sin1;
        f32x4 gn0 = (f32x4){1.f, 1.f, 1.f, 1.f}, gn1 = gn0;
        if (grpA) { const float* gn = (isq ? qn : kn) + dbase; gn0 = *(const GAS f32x4*)gn; gn1 = *(const GAS f32x4*)(gn + 4); }
#pragma unroll
        for (int ai = 0; ai < 2; ++ai) {
            f32x4 c4v[4], s4v[4];
#pragma unroll
            for (int m = 0; m < 4; ++m) { const int pos = (u.pm * 256 + rl0 + ai * 128 + m * 16) & (SEQ - 1);
                c4v[m] = *(const GAS f32x4*)(ctab + pos * 32 + i0); s4v[m] = *(const GAS f32x4*)(stab + pos * 32 + i0); }
#pragma unroll
            for (int m = 0; m < 4; ++m) {
                const int rl = rl0 + ai * 128 + m * 16, row = u.pm * 256 + rl, pos = row & (SEQ - 1);
                const f32x4 c4 = c4v[m], s4 = s4v[m];
#pragma unroll
                for (int bj = 0; bj < 2; ++bj) {
                    f32x4 a = acc[ai][bj][m][0], b = acc[ai][bj][m][1];
                    if (hasV && bj == 1) {
                        bf16_t* vp = Vt + ((size_t)((((pn == 5 ? 1 : 0) * NSEQ + (row >> 11)) * 2 + (wc >> 1)) * 64 + dbase)) * SEQ + pos;
                        const u32x4 w = pack8(a, b);
                        *(GAS bf16_t*)(vp + 0 * SEQ) = (bf16_t)(w.x & 0xffffu); *(GAS bf16_t*)(vp + 1 * SEQ) = (bf16_t)(w.x >> 16);
                        *(GAS bf16_t*)(vp + 2 * SEQ) = (bf16_t)(w.y & 0xffffu); *(GAS bf16_t*)(vp + 3 * SEQ) = (bf16_t)(w.y >> 16);
                        *(GAS bf16_t*)(vp + 4 * SEQ) = (bf16_t)(w.z & 0xffffu); *(GAS bf16_t*)(vp + 5 * SEQ) = (bf16_t)(w.z >> 16);
                        *(GAS bf16_t*)(vp + 6 * SEQ) = (bf16_t)(w.w & 0xffffu); *(GAS bf16_t*)(vp + 7 * SEQ) = (bf16_t)(w.w >> 16);
                    } else {
                        if (grpA) {
                            const LAS float* xp = xch + (rl * 2 + bj) * 4 + (wc & 2);
                            const float tot = xp[0] + xp[1];
                            const float rstd = __builtin_amdgcn_rsqf(tot * (1.f / 64.f) + QK_EPS);
                            a = a * rstd * gn0; b = b * rstd * gn1;
                        }
                        f32x4 oa, ob;
                        oa[0] = a[0] * c4[0] - a[1] * s4[0]; oa[1] = a[0] * s4[0] + a[1] * c4[0];
                        oa[2] = a[2] * c4[1] - a[3] * s4[1]; oa[3] = a[2] * s4[1] + a[3] * c4[1];
                        ob[0] = b[0] * c4[2] - b[1] * s4[2]; ob[1] = b[0] * s4[2] + b[1] * c4[2];
                        ob[2] = b[2] * c4[3] - b[3] * s4[3]; ob[3] = b[2] * s4[3] + b[3] * c4[3];
                        if (isq) { oa = oa * QSCALE; ob = ob * QSCALE; }
                        *(GAS u32x4*)(H + (size_t)row * INW + col0 + bj * 128) = pack8(oa, ob);
                    }
                }
            }
            asm volatile("" ::: "memory");
        }
    }
};
template <bool HASG> struct EpiRes {
    static constexpr bool PERM = true, AFTER_DRAIN = false;
    const bf16_t* X; const bf16_t* G; float* Y; bf16_t* Yb; bool yf32; bool fromY; const float* ST; const float* lng; const float* lnb; bf16_t* Yw;
    __device__ __forceinline__ void operator()(const f32x4 (&acc)[2][2][4][2], const pg8::Unit& u, int wr, int wc, int fr, int fq) const {
        { int t_ = threadIdx.x; asm volatile("" : "+v"(t_)); fr = t_ & 15; fq = (t_ >> 4) & 3; }
        const int row0 = u.pm * 256 + wr * 64 + fr, col0 = u.pn * 256 + wc * 32 + 8 * fq;
#pragma unroll
        for (int bj = 0; bj < 2; ++bj) {
            f32x4 g0, g1, b0, b1;
            if (fromY) { g0 = *(const GAS f32x4*)(lng + col0 + bj * 128); g1 = *(const GAS f32x4*)(lng + col0 + bj * 128 + 4); b0 = *(const GAS f32x4*)(lnb + col0 + bj * 128); b1 = *(const GAS f32x4*)(lnb + col0 + bj * 128 + 4); }
#pragma unroll
            for (int ai = 0; ai < 2; ++ai) {
                u32x4 win[4], wg[4]; float smean[4], srstd[4];
#pragma unroll
                for (int m = 0; m < 4; ++m) {
                    const int row = row0 + ai * 128 + m * 16; const size_t off = (size_t)row * DM + col0 + bj * 128;
                    if (fromY) { typedef float f2_ __attribute__((ext_vector_type(2))); const f2_ st = *(const GAS f2_*)(ST + 2 * (size_t)row); smean[m] = st[0]; srstd[m] = st[1]; win[m] = *(const GAS u32x4*)(Yb + off); }
                    else { smean[m] = 0.f; srstd[m] = 1.f; win[m] = *(const GAS u32x4*)(X + off); }
                    if (HASG) wg[m] = *(const GAS u32x4*)(G + off);
                }
#pragma unroll
                for (int m = 0; m < 4; ++m) {
                    const int row = row0 + ai * 128 + m * 16; const size_t off = (size_t)row * DM + col0 + bj * 128;
                    f32x4 xa, xb; unpack8(win[m], xa, xb);
                    if (fromY) { xa = (xa - smean[m]) * srstd[m] * g0 + b0; xb = (xb - smean[m]) * srstd[m] * g1 + b1; }
                    f32x4 y0 = xa * ALPHA + acc[ai][bj][m][0], y1 = xb * ALPHA + acc[ai][bj][m][1];
                    if (HASG) { f32x4 ga, gb; unpack8(wg[m], ga, gb); y0 += ga; y1 += gb; }
                    if (yf32) { *(GAS f32x4*)(Y + off) = y0; *(GAS f32x4*)(Y + off + 4) = y1; }
                    else *(GAS u32x4*)(Yw + off) = pack8(y0, y1);
                }
                asm volatile("" ::: "memory");
            }
        }
    }
};
struct EpiGate {
    static constexpr bool PERM = true, AFTER_DRAIN = false;
    bf16_t* G; const float* bias;
    __device__ __forceinline__ void operator()(const f32x4 (&acc)[2][2][4][2], const pg8::Unit& u, int wr, int wc, int fr, int fq) const {
        { int t_ = threadIdx.x; asm volatile("" : "+v"(t_)); fr = t_ & 15; fq = (t_ >> 4) & 3; }
        const int row0 = u.pm * 256 + wr * 64 + fr, col0 = u.pn * 256 + wc * 32 + 8 * fq;
#pragma unroll
        for (int bj = 0; bj < 2; ++bj) {
            const f32x4 bv0 = *(const GAS f32x4*)(bias + col0 + bj * 128), bv1 = *(const GAS f32x4*)(bias + col0 + bj * 128 + 4);
#pragma unroll
            for (int ai = 0; ai < 2; ++ai)
#pragma unroll
                for (int m = 0; m < 4; ++m) {
                    const size_t off = (size_t)(row0 + ai * 128 + m * 16) * DM + col0 + bj * 128;
                    f32x4 a = acc[ai][bj][m][0] + bv0, b = acc[ai][bj][m][1] + bv1;
#pragma unroll
                    for (int j = 0; j < 4; ++j) { a[j] = sigmoidf_(a[j]); b[j] = sigmoidf_(b[j]); }
                    *(GAS u32x4*)(G + off) = pack8(a, b);
                    asm volatile("" ::: "memory");
                }
        }
    }
};
struct EpiPle {
    static constexpr bool PERM = true, AFTER_DRAIN = false;
    bf16_t* G;
    __device__ __forceinline__ void operator()(const f32x4 (&acc)[2][2][4][2], const pg8::Unit& u, int wr, int wc, int fr, int fq) const {
        { int t_ = threadIdx.x; asm volatile("" : "+v"(t_)); fr = t_ & 15; fq = (t_ >> 4) & 3; }
        const int row0 = u.pm * 256 + wr * 64 + fr, col0 = u.pn * 256 + wc * 32 + 8 * fq;
#pragma unroll
        for (int ai = 0; ai < 2; ++ai)
#pragma unroll
            for (int bj = 0; bj < 2; ++bj) {
                u32x4 wg[4];
#pragma unroll
                for (int m = 0; m < 4; ++m) wg[m] = *(const GAS u32x4*)(G + (size_t)(row0 + ai * 128 + m * 16) * DM + col0 + bj * 128);
#pragma unroll
                for (int m = 0; m < 4; ++m) {
                    f32x4 ga, gb; unpack8(wg[m], ga, gb);
                    *(GAS u32x4*)(G + (size_t)(row0 + ai * 128 + m * 16) * DM + col0 + bj * 128) = pack8(ga * acc[ai][bj][m][0], gb * acc[ai][bj][m][1]);
                }
                asm volatile("" ::: "memory");
            }
    }
};
struct EpiUp {
    static constexpr bool PERM = true, AFTER_DRAIN = false;
    bf16_t* U; float* EG; float* EC; float* EV; const float* cw; const float* cb; LAS float* xch;
    __device__ __forceinline__ void operator()(const f32x4 (&acc)[2][2][4][2], const pg8::Unit& u, int wr, int wc, int fr, int fq) const {
        { int t_ = threadIdx.x; asm volatile("" : "+v"(t_)); fr = t_ & 15; fq = (t_ >> 4) & 3; }
        const int chl = wc * 32 + 8 * fq, ch0 = u.pn * 128 + chl;
        LAS float* first = xch; LAS float* last = xch + 16 * 128; LAS float* cst = xch + 32 * 128;
        { int t_ = threadIdx.x; asm volatile("" : "+v"(t_)); const int kk = t_ >> 7, cc = t_ & 127;
          cst[t_] = (kk < 3) ? *(const GAS float*)(cw + kk * DFF + u.pn * 128 + cc) : *(const GAS float*)(cb + u.pn * 128 + cc); }
#pragma unroll
        for (int ai = 0; ai < 2; ++ai)
#pragma unroll
            for (int m = 0; m < 4; ++m) { const int grp = ai * 8 + wr * 4 + m;
                if (fr == 0) { *(LAS f32x4*)(first + grp * 128 + chl) = acc[ai][0][m][0]; *(LAS f32x4*)(first + grp * 128 + chl + 4) = acc[ai][0][m][1]; }
                if (fr == 15) { *(LAS f32x4*)(last + grp * 128 + chl) = acc[ai][0][m][0]; *(LAS f32x4*)(last + grp * 128 + chl + 4) = acc[ai][0][m][1]; } }
        asm volatile("s_waitcnt lgkmcnt(0)" ::: "memory"); __builtin_amdgcn_s_barrier(); asm volatile("" ::: "memory");
#pragma unroll
        for (int ai = 0; ai < 2; ++ai)
#pragma unroll
            for (int m = 0; m < 4; ++m) {
                const int grp = ai * 8 + wr * 4 + m;
                const f32x4 g0 = acc[ai][0][m][0], g1 = acc[ai][0][m][1], v0 = acc[ai][1][m][0], v1 = acc[ai][1][m][1];
                f32x4 up0, up1, dn0, dn1;
#pragma unroll
                for (int j = 0; j < 4; ++j) { up0[j] = dpp_shr1(g0[j]); up1[j] = dpp_shr1(g1[j]); dn0[j] = dpp_shl1(g0[j]); dn1[j] = dpp_shl1(g1[j]); }
                const int gp = grp > 0 ? grp - 1 : 0, gn = grp < 15 ? grp + 1 : 15;
                f32x4 l0 = *(const LAS f32x4*)(last + gp * 128 + chl), l1 = *(const LAS f32x4*)(last + gp * 128 + chl + 4);
                f32x4 f0 = *(const LAS f32x4*)(first + gn * 128 + chl), f1 = *(const LAS f32x4*)(first + gn * 128 + chl + 4);
                if (grp == 0) { l0 = (f32x4){0.f, 0.f, 0.f, 0.f}; l1 = l0; }
                if (grp == 15) { f0 = (f32x4){0.f, 0.f, 0.f, 0.f}; f1 = f0; }
                if (fr == 0) { up0 = l0; up1 = l1; }
                if (fr == 15) { dn0 = f0; dn1 = f1; }
                f32x4 c0, c1;
                { const f32x4 w0a = *(const LAS f32x4*)(cst + chl), w1a = *(const LAS f32x4*)(cst + 128 + chl), w2a = *(const LAS f32x4*)(cst + 256 + chl), cba = *(const LAS f32x4*)(cst + 384 + chl);
                  c0 = w0a * up0 + w1a * g0 + w2a * dn0 + cba; }
                { const f32x4 w0b = *(const LAS f32x4*)(cst + chl + 4), w1b = *(const LAS f32x4*)(cst + 128 + chl + 4), w2b = *(const LAS f32x4*)(cst + 256 + chl + 4), cbb = *(const LAS f32x4*)(cst + 384 + chl + 4);
                  c1 = w0b * up1 + w1b * g1 + w2b * dn1 + cbb; }
                f32x4 u0, u1;
#pragma unroll
                for (int j = 0; j < 4; ++j) { u0[j] = gelu_tanh(c0[j]) * v0[j]; u1[j] = gelu_tanh(c1[j]) * v1[j]; }
                const int row = u.pm * 256 + grp * 16 + fr;
                *(GAS u32x4*)(U + (size_t)row * DFF + ch0) = pack8(u0, u1);
                if (grp == 0 && fr == 0) { const size_t e = ((size_t)u.pm * 2 + 0) * DFF + ch0;
                    *(GAS f32x4*)(EG + e) = g0; *(GAS f32x4*)(EG + e + 4) = g1; *(GAS f32x4*)(EC + e) = c0; *(GAS f32x4*)(EC + e + 4) = c1; *(GAS f32x4*)(EV + e) = v0; *(GAS f32x4*)(EV + e + 4) = v1; }
                if (grp == 15 && fr == 15) { const size_t e = ((size_t)u.pm * 2 + 1) * DFF + ch0;
                    *(GAS f32x4*)(EG + e) = g0; *(GAS f32x4*)(EG + e + 4) = g1; *(GAS f32x4*)(EC + e) = c0; *(GAS f32x4*)(EC + e + 4) = c1; *(GAS f32x4*)(EV + e) = v0; *(GAS f32x4*)(EV + e + 4) = v1; }
                asm volatile("" ::: "memory");
            }
    }
};

__device__ __forceinline__ void ln_row(const float* src, const float* g, const float* b, bf16_t* dstb, float* dstf, int lane) {
    const f32x4* xr = (const f32x4*)src + lane;
    f32x4 v[4]; float s = 0.f;
#pragma unroll
    for (int j = 0; j < 4; ++j) { v[j] = xr[64 * j]; s += (v[j][0] + v[j][1]) + (v[j][2] + v[j][3]); }
    const float mean = wave_sum(s) * (1.f / DM); float s2 = 0.f;
#pragma unroll
    for (int j = 0; j < 4; ++j) { v[j] = v[j] - mean; s2 += (v[j][0] * v[j][0] + v[j][1] * v[j][1]) + (v[j][2] * v[j][2] + v[j][3] * v[j][3]); }
    const float rstd = 1.f / sqrtf(wave_sum(s2) * (1.f / DM) + LN_EPS);
#pragma unroll
    for (int j = 0; j < 4; ++j) {
        const f32x4 gg = ((const GAS f32x4*)g)[lane + 64 * j], bb = ((const GAS f32x4*)b)[lane + 64 * j];
        const f32x4 o = v[j] * rstd * gg + bb;
        if (dstf) ((GAS f32x4*)dstf)[lane + 64 * j] = o;
        if (dstb) { u32x2 w; w.x = pk2(o[0], o[1]); w.y = pk2(o[2], o[3]); ((GAS u32x2*)dstb)[lane + 64 * j] = w; }
    }
}

__device__ __forceinline__ void ln_rows4(const float* src0, const float* g, const float* b, bf16_t* dstb0, float* dstf0, int lane) {
    f32x4 v[4][4]; float s[4], s2[4];
#pragma unroll
    for (int r = 0; r < 4; ++r)
#pragma unroll
        for (int j = 0; j < 4; ++j) v[r][j] = ((const GAS f32x4*)(src0 + (size_t)r * DM))[lane + 64 * j];
#pragma unroll
    for (int r = 0; r < 4; ++r) { s[r] = 0.f;
#pragma unroll
        for (int j = 0; j < 4; ++j) s[r] += (v[r][j][0] + v[r][j][1]) + (v[r][j][2] + v[r][j][3]); }
#pragma unroll
    for (int o = 1; o < 64; o <<= 1)
#pragma unroll
        for (int r = 0; r < 4; ++r) s[r] += __shfl_xor(s[r], o);
#pragma unroll
    for (int r = 0; r < 4; ++r) { const float mean = s[r] * (1.f / DM); s2[r] = 0.f;
#pragma unroll
        for (int j = 0; j < 4; ++j) { v[r][j] = v[r][j] - mean; s2[r] += (v[r][j][0] * v[r][j][0] + v[r][j][1] * v[r][j][1]) + (v[r][j][2] * v[r][j][2] + v[r][j][3] * v[r][j][3]); } }
#pragma unroll
    for (int o = 1; o < 64; o <<= 1)
#pragma unroll
        for (int r = 0; r < 4; ++r) s2[r] += __shfl_xor(s2[r], o);
#pragma unroll
    for (int j = 0; j < 4; ++j) {
        const f32x4 gg = ((const GAS f32x4*)g)[lane + 64 * j], bb = ((const GAS f32x4*)b)[lane + 64 * j];
#pragma unroll
        for (int r = 0; r < 4; ++r) {
            const float rstd = 1.f / sqrtf(s2[r] * (1.f / DM) + LN_EPS);
            const f32x4 o = v[r][j] * rstd * gg + bb;
            if (dstf0) ((GAS f32x4*)(dstf0 + (size_t)r * DM))[lane + 64 * j] = o;
            if (dstb0) { u32x2 w; w.x = pk2(o[0], o[1]); w.y = pk2(o[2], o[3]); ((GAS u32x2*)(dstb0 + (size_t)r * DM))[lane + 64 * j] = w; }
        }
    }
}

__device__ __forceinline__ void ln_rows4_bf16(const bf16_t* src0, const float* g, const float* b, bf16_t* dstb0, float* st0, int lane, float* dstf0 = nullptr) {
    u32x4 w[4][2]; f32x4 v[4][4]; float s[4], s2[4];
#pragma unroll
    for (int r = 0; r < 4; ++r) { w[r][0] = *(const GAS u32x4*)(src0 + (size_t)r * DM + 8 * lane); w[r][1] = *(const GAS u32x4*)(src0 + (size_t)r * DM + 512 + 8 * lane); }
#pragma unroll
    for (int r = 0; r < 4; ++r) { unpack8(w[r][0], v[r][0], v[r][1]); unpack8(w[r][1], v[r][2], v[r][3]); s[r] = 0.f;
#pragma unroll
        for (int j = 0; j < 4; ++j) s[r] += (v[r][j][0] + v[r][j][1]) + (v[r][j][2] + v[r][j][3]); }
#pragma unroll
    for (int o = 1; o < 64; o <<= 1)
#pragma unroll
        for (int r = 0; r < 4; ++r) s[r] += __shfl_xor(s[r], o);
#pragma unroll
    for (int r = 0; r < 4; ++r) { const float mean = s[r] * (1.f / DM); s2[r] = 0.f;
#pragma unroll
        for (int j = 0; j < 4; ++j) { v[r][j] = v[r][j] - mean; s2[r] += (v[r][j][0] * v[r][j][0] + v[r][j][1] * v[r][j][1]) + (v[r][j][2] * v[r][j][2] + v[r][j][3] * v[r][j][3]); } }
#pragma unroll
    for (int o = 1; o < 64; o <<= 1)
#pragma unroll
        for (int r = 0; r < 4; ++r) s2[r] += __shfl_xor(s2[r], o);
    f32x4 gg[4], bb[4];
#pragma unroll
    for (int j = 0; j < 4; ++j) { const int c = (j >> 1) * 512 + 8 * lane + 4 * (j & 1); gg[j] = *(const GAS f32x4*)(g + c); bb[j] = *(const GAS f32x4*)(b + c); }
#pragma unroll
    for (int r = 0; r < 4; ++r) {
        const float rstd = 1.f / sqrtf(s2[r] * (1.f / DM) + LN_EPS);
        if (st0 && lane == 0) { typedef float f2_ __attribute__((ext_vector_type(2))); *(GAS f2_*)(st0 + 2 * r) = (f2_){s[r] * (1.f / DM), rstd}; }
        f32x4 o[4];
#pragma unroll
        for (int j = 0; j < 4; ++j) o[j] = v[r][j] * rstd * gg[j] + bb[j];
        if (dstf0) { float* dr = dstf0 + (size_t)r * DM + 8 * lane; *(GAS f32x4*)dr = o[0]; *(GAS f32x4*)(dr + 4) = o[1]; *(GAS f32x4*)(dr + 512) = o[2]; *(GAS f32x4*)(dr + 516) = o[3]; }
        else { *(GAS u32x4*)(dstb0 + (size_t)r * DM + 8 * lane) = pack8(o[0], o[1]); *(GAS u32x4*)(dstb0 + (size_t)r * DM + 512 + 8 * lane) = pack8(o[2], o[3]); }
    }
}

__device__ __forceinline__ void transpose_item(const float* W, int K, int N, bf16_t* WT, LAS float* scr, int item, int lane, bool upmap) {
    const int nblk = N / 32, kb = item / nblk, nb = item % nblk, k0 = 64 * kb, n0 = 32 * nb;
    { float tv[32];
#pragma unroll
      for (int i = 0; i < 32; ++i) tv[i] = ((const GAS float*)W)[(size_t)(k0 + 2 * i + (lane >> 5)) * N + n0 + (lane & 31)];
#pragma unroll
      for (int i = 0; i < 32; ++i) scr[(2 * i + (lane >> 5)) * 33 + (lane & 31)] = tv[i]; }
    asm volatile("s_waitcnt lgkmcnt(0)" ::: "memory");
    int d0 = n0;
    if (upmap) { const int bj = n0 >= DFF ? 1 : 0, c = n0 - bj * DFF; d0 = 256 * (c / 128) + 128 * bj + (c % 128); }
    const int c = lane & 7;
#pragma unroll
    for (int j = 0; j < 4; ++j) { const int n = (lane >> 3) + 8 * j; const LAS float* s = scr + (8 * c) * 33 + n;
        u32x4 o; o.x = pk2(s[0 * 33], s[1 * 33]); o.y = pk2(s[2 * 33], s[3 * 33]); o.z = pk2(s[4 * 33], s[5 * 33]); o.w = pk2(s[6 * 33], s[7 * 33]);
        *(GAS u32x4*)(WT + (size_t)(d0 + n) * K + k0 + 8 * c) = o; }
    asm volatile("s_waitcnt lgkmcnt(0)" ::: "memory");
}

template <class TAB> __device__ __forceinline__ void convert_layer(const TAB& in, unsigned char* ws, int l, LAS unsigned char* lds, int gw, int NGW, int wave, int lane, size_t gt, size_t NT) {
    LAS float* scr = (LAS float*)(lds + wave * 16384);
    bf16_t* Wl = (bf16_t*)(ws + WS_W);
    constexpr int I_IN = (DM / 64) * (INW / 32), I_OUT = (DM / 64) * (DM / 32), I_UP = (DM / 64) * (2 * DFF / 32), I_DOWN = (DFF / 64) * (DM / 32), I_PLE = (DPLE / 64) * (DM / 32), I_GATE = I_OUT;
    constexpr int NITEMS = I_IN + I_OUT + I_UP + I_DOWN + I_PLE + I_GATE;
    for (int it = gw; it < NITEMS; it += NGW) {
        int r = it;
        if (r < I_IN) { transpose_item(in[I_WIN] + (size_t)l * DM * INW, DM, INW, Wl + W_IN, scr, r, lane, false); continue; } r -= I_IN;
        if (r < I_OUT) { transpose_item(in[I_WOUT] + (size_t)l * DM * DM, DM, DM, Wl + W_OUT, scr, r, lane, false); continue; } r -= I_OUT;
        if (r < I_UP) { transpose_item(in[I_WUP] + (size_t)l * DM * 2 * DFF, DM, 2 * DFF, Wl + W_UP, scr, r, lane, true); continue; } r -= I_UP;
        if (r < I_DOWN) { transpose_item(in[I_WDOWN] + (size_t)l * DFF * DM, DFF, DM, Wl + W_DOWN, scr, r, lane, false); continue; } r -= I_DOWN;
        if (r < I_PLE) { transpose_item(in[I_WPLE] + (size_t)l * DPLE * DM, DPLE, DM, Wl + W_PLE, scr, r, lane, false); continue; } r -= I_PLE;
        transpose_item(in[I_WGATE] + (size_t)l * DM * DM, DM, DM, Wl + W_GATE, scr, r, lane, false);
    }
    bf16_t* Pb = (bf16_t*)(ws + WS_P);
    const size_t NV8 = (size_t)MTOK * (DPLE / 8);
    size_t i = gt;
    for (; i + 3 * NT < NV8; i += 4 * NT) {
        f32x4 va[4], vb[4];
#pragma unroll
        for (int u = 0; u < 4; ++u) { const size_t ii = i + u * NT, m = ii / (DPLE / 8), c8 = ii % (DPLE / 8);
            const float* src = (m < (size_t)MP) ? in[I_PP] + ((size_t)l * MP + m) * DPLE : in[I_PS] + ((size_t)l * (MTOK - MP) + (m - MP)) * DPLE;
            va[u] = *(const GAS f32x4*)(src + 8 * c8); vb[u] = *(const GAS f32x4*)(src + 8 * c8 + 4); }
#pragma unroll
        for (int u = 0; u < 4; ++u) { const size_t ii = i + u * NT, m = ii / (DPLE / 8), c8 = ii % (DPLE / 8);
            *(GAS u32x4*)(Pb + m * DPLE + 8 * c8) = pack8(va[u], vb[u]); }
    }
    for (; i < NV8; i += NT) {
        const size_t m = i / (DPLE / 8), c8 = i % (DPLE / 8);
        const float* src = (m < (size_t)MP) ? in[I_PP] + ((size_t)l * MP + m) * DPLE : in[I_PS] + ((size_t)l * (MTOK - MP) + (m - MP)) * DPLE;
        *(GAS u32x4*)(Pb + m * DPLE + 8 * c8) = pack8(*(const GAS f32x4*)(src + 8 * c8), *(const GAS f32x4*)(src + 8 * c8 + 4));
    }
}

namespace att {
constexpr int ROWB = 144, TILEB = 64 * ROWB;
__device__ __forceinline__ int pi_slot(int s) { return (s & 3) + 4 * ((s >> 3) & 1) + 8 * ((s >> 2) & 1) + 16 * (s >> 4); }
#define MFMA32(a, b, c) __builtin_amdgcn_mfma_f32_32x32x16_bf16((a), (b), (c), 0, 0, 0)
__device__ __forceinline__ float max3f(float a, float b, float c) { return fmaxf(fmaxf(a, b), c); }
template <bool WIN>
__device__ __forceinline__ void attn_unit(LAS unsigned char* lds, const bf16_t* __restrict__ H, const bf16_t* __restrict__ Vt, bf16_t* __restrict__ O, int b, int qblk, const float* sinkp, const float* gainp, bool nomax) {
    int tid_ = threadIdx.x; asm volatile("" : "+v"(tid_));
    const int tid = tid_, lane = tid & 63, r32 = lane & 31, hi = lane >> 5, wid = tid >> 6;
    const int q0 = 64 * qblk, head = wid, kh = wid >> 2;
    const size_t rowbase = (size_t)b * SEQ;
    const bf16_t* Qp = H + (rowbase + q0 + r32) * INW + (WIN ? 768 : 0) + head * 64 + 8 * hi;
    bf16x8 qf[2][4];
#pragma unroll
    for (int qs = 0; qs < 2; ++qs)
#pragma unroll
        for (int c = 0; c < 4; ++c) qf[qs][c] = *(const GAS bf16x8*)(Qp + (size_t)(32 * qs) * INW + 16 * c);
    const int lrow = tid >> 3, lch = tid & 7;
    const bf16_t* Kp = H + (rowbase + lrow) * INW + (WIN ? 1280 : 512) + 8 * lch;
    const bf16_t* Vp = Vt + ((size_t)(((WIN ? 1 : 0) * NSEQ + b) * 2) * 64 + lrow) * SEQ + 8 * lch;
    const int t_lo = WIN ? (qblk - 2 < 0 ? 0 : qblk - 2) : 0, t_hi = WIN ? (qblk + 2 > 31 ? 31 : qblk + 2) : 31;
    LAS unsigned char* Kl = lds; LAS unsigned char* Vl = lds + 4 * TILEB;
    const int stoff = lrow * ROWB + lch * 16;
    float mrun[2], lrun[2]; f32x16 o[2][2];
#pragma unroll
    for (int qs = 0; qs < 2; ++qs) {
        if (WIN) { mrun[qs] = sinkp[head] * LOG2E; lrun[qs] = hi == 0 ? 1.f : 0.f; } else { mrun[qs] = 0.f; lrun[qs] = 0.f; }
#pragma unroll
        for (int dh = 0; dh < 2; ++dh)
#pragma unroll
            for (int r = 0; r < 16; ++r) o[qs][dh][r] = 0.f;
    }
    u32x4 kreg[2], vreg[2];
#pragma unroll
    for (int kk = 0; kk < 2; ++kk) { kreg[kk] = *(const GAS u32x4*)(Kp + (size_t)(64 * t_lo) * INW + 64 * kk); vreg[kk] = *(const GAS u32x4*)(Vp + 64 * t_lo + (size_t)kk * 64 * SEQ); }
#pragma unroll
    for (int kk = 0; kk < 2; ++kk) { *(LAS u32x4*)(Kl + kk * TILEB + stoff) = kreg[kk]; *(LAS u32x4*)(Vl + kk * TILEB + stoff) = vreg[kk]; }
    __syncthreads();
    const int koff = pi_slot(r32) * ROWB + 16 * hi, voff = r32 * ROWB + 16 * hi;
    for (int t = t_lo; t <= t_hi; ++t) {
        const int buf = (t - t_lo) & 1;
        if (t < t_hi) {
#pragma unroll
            for (int kk = 0; kk < 2; ++kk) { kreg[kk] = *(const GAS u32x4*)(Kp + (size_t)(64 * (t + 1)) * INW + 64 * kk); vreg[kk] = *(const GAS u32x4*)(Vp + 64 * (t + 1) + (size_t)kk * 64 * SEQ); }
        }
        const LAS unsigned char* Kb = Kl + (2 * buf + kh) * TILEB; const LAS unsigned char* Vb = Vl + (2 * buf + kh) * TILEB;
        const bool mk = WIN && (t < qblk - 1 || t > qblk + 1);
        bf16x8 kf[4]; bf16x8 vf[2][2]; f32x16 pq[2][2];
#define ATT_LDK(H2) do { _Pragma("unroll") for (int c = 0; c < 4; ++c) kf[c] = *(const LAS bf16x8*)(Kb + (H2) * 32 * ROWB + koff + 32 * c); } while (0)
#define ATT_LDV(H2) do { _Pragma("unroll") for (int dh = 0; dh < 2; ++dh) _Pragma("unroll") for (int s_ = 0; s_ < 2; ++s_) vf[dh][s_] = *(const LAS bf16x8*)(Vb + dh * 32 * ROWB + voff + 32 * (2 * (H2) + s_)); } while (0)
#define ATT_QK(H2, QS) do { _Pragma("unroll") for (int r = 0; r < 16; ++r) pq[H2][QS][r] = 0.f; _Pragma("unroll") for (int c = 0; c < 4; ++c) pq[H2][QS] = MFMA32(kf[c], qf[QS][c], pq[H2][QS]); } while (0)
#define ATT_SMPV(H2, QS) do { \
            f32x16 d; \
            if (!WIN && nomax) d = pq[H2][QS];     \
            else { \
            const float nm_ = -mrun[QS]; \
            d = pq[H2][QS] + nm_; \
            if (mk) { const int q = q0 + 32 * (QS) + r32; \
                _Pragma("unroll") for (int r = 0; r < 16; ++r) { const int key = 64 * t + 32 * (H2) + (r & 3) + 4 * ((r >> 2) & 1) + 8 * hi + 16 * (r >> 3); const int dd = key - q; if (dd > 128 || dd < -128) d[r] = -INFINITY; } } \
            float mx; \
            { float a = max3f(d[0], d[1], d[2]), b = max3f(d[3], d[4], d[5]); \
              a = max3f(a, d[6], d[7]); b = max3f(b, d[8], d[9]); a = max3f(a, d[10], d[11]); b = max3f(b, d[12], d[13]); a = max3f(a, d[14], d[15]); mx = fmaxf(a, b); } \
            { auto rr = __builtin_amdgcn_permlane32_swap(__float_as_uint(mx), __float_as_uint(mx), false, false); mx = fmaxf(__uint_as_float(rr[0]), __uint_as_float(rr[1])); } \
            const bool first = !WIN && (H2) == 0 && t == t_lo; \
            if (first || __any(mx > 8.f)) {     \
                const float dl = first ? mx : fmaxf(mx, 0.f); \
                const float alpha = fast_exp2(-dl); \
                mrun[QS] += dl; lrun[QS] *= alpha; \
                _Pragma("unroll") for (int dh = 0; dh < 2; ++dh) _Pragma("unroll") for (int r = 0; r < 16; ++r) o[QS][dh][r] *= alpha; \
                { const float ndl = -dl; d = d + ndl; } \
            } \
            } \
            _Pragma("unroll") for (int r = 0; r < 16; ++r) d[r] = fast_exp2(d[r]); \
            { typedef float f32x8 __attribute__((ext_vector_type(8))); \
              const f32x8 s8 = __builtin_shufflevector(d, d, 0, 1, 2, 3, 4, 5, 6, 7) + __builtin_shufflevector(d, d, 8, 9, 10, 11, 12, 13, 14, 15); \
              const f32x4 s4 = __builtin_shufflevector(s8, s8, 0, 1, 2, 3) + __builtin_shufflevector(s8, s8, 4, 5, 6, 7); \
              lrun[QS] += (s4[0] + s4[1]) + (s4[2] + s4[3]); } \
            u32x4 pb0, pb1; \
            _Pragma("unroll") for (int w = 0; w < 4; ++w) { pb0[w] = pk2(d[2 * w], d[2 * w + 1]); pb1[w] = pk2(d[8 + 2 * w], d[8 + 2 * w + 1]); } \
            _Pragma("unroll") for (int dh = 0; dh < 2; ++dh) { \
                o[QS][dh] = MFMA32(vf[dh][0], __builtin_bit_cast(bf16x8, pb0), o[QS][dh]); \
                o[QS][dh] = MFMA32(vf[dh][1], __builtin_bit_cast(bf16x8, pb1), o[QS][dh]); } \
        } while (0)
        ATT_LDK(0); ATT_QK(0, 0); ATT_QK(0, 1); ATT_LDV(0);
        ATT_SMPV(0, 0); ATT_LDK(1); ATT_QK(1, 0);
        ATT_SMPV(0, 1); ATT_QK(1, 1); ATT_LDV(1);
        ATT_SMPV(1, 0);
        ATT_SMPV(1, 1);
#undef ATT_LDK
#undef ATT_LDV
#undef ATT_QK
#undef ATT_SMPV
        if (t < t_hi) {
#pragma unroll
            for (int kk = 0; kk < 2; ++kk) { *(LAS u32x4*)(Kl + (2 * (buf ^ 1) + kk) * TILEB + stoff) = kreg[kk]; *(LAS u32x4*)(Vl + (2 * (buf ^ 1) + kk) * TILEB + stoff) = vreg[kk]; }
        }
        __syncthreads();
    }
    LAS float* xs = (LAS float*)(lds + 8 * TILEB);
#pragma unroll
    for (int qs = 0; qs < 2; ++qs) {
        const float lt = lrun[qs] + __shfl_xor(lrun[qs], 32);
        const float inv = 1.0f / lt;
        float ss = 0.f;
#pragma unroll
        for (int dh = 0; dh < 2; ++dh)
#pragma unroll
            for (int r = 0; r < 16; ++r) { const float v = o[qs][dh][r] * inv; o[qs][dh][r] = v; ss += v * v; }
        ss += __shfl_xor(ss, 32);
        if (hi == 0) xs[(32 * qs + r32) * 8 + wid] = ss;
    }
    __syncthreads();
#pragma unroll
    for (int qs = 0; qs < 2; ++qs) {
        const f32x4 x0 = *(const LAS f32x4*)(xs + (32 * qs + r32) * 8), x1 = *(const LAS f32x4*)(xs + (32 * qs + r32) * 8 + 4);
        const float tot = ((x0[0] + x0[1]) + (x0[2] + x0[3])) + ((x1[0] + x1[1]) + (x1[2] + x1[3]));
        const float rn = 1.f / sqrtf(tot * (1.f / 512.f) + LN_EPS);
        bf16_t* Op = O + (rowbase + q0 + 32 * qs + r32) * DM + (WIN ? 512 : 0) + head * 64;
        const float* gp = gainp + head * 64 + 4 * hi;
#pragma unroll
        for (int dh = 0; dh < 2; ++dh)
#pragma unroll
            for (int ip = 0; ip < 2; ++ip) {
                u32x2 w[2];
#pragma unroll
                for (int e = 0; e < 2; ++e) { const int i = 2 * ip + e; const f32x4 g = *(const GAS f32x4*)(gp + 32 * dh + 8 * i);
                    w[e].x = pk2(o[qs][dh][4 * i] * rn * g[0], o[qs][dh][4 * i + 1] * rn * g[1]); w[e].y = pk2(o[qs][dh][4 * i + 2] * rn * g[2], o[qs][dh][4 * i + 3] * rn * g[3]); }
                auto rx = __builtin_amdgcn_permlane32_swap(w[0].x, w[1].x, false, false);
                auto ry = __builtin_amdgcn_permlane32_swap(w[0].y, w[1].y, false, false);
                u32x4 w4; w4.x = rx[0]; w4.y = ry[0]; w4.z = rx[1]; w4.w = ry[1];
                *(GAS u32x4*)(Op + 32 * dh + 8 * (2 * ip + hi)) = w4;
            }
    }
}
}

#define XB_TMO      128
#define XB_XCNT(j)  (256  + 64 * (j))
#define XB_XSUB(j)  (1280 + 64 * (j))
#define XB_XGEN(j)  (2304 + 64 * (j))
#define XB_TOP      3328
#define XB_TOPGEN   3392
#define XCD_BAR_WORDS 3456
#define XB_SPIN_CAP (1u << 18)

__device__ __forceinline__ unsigned xb_ld(unsigned* p)              { return __hip_atomic_load(p, __ATOMIC_RELAXED, __HIP_MEMORY_SCOPE_AGENT); }
__device__ __forceinline__ unsigned xb_add(unsigned* p, unsigned v) { return __hip_atomic_fetch_add(p, v, __ATOMIC_RELAXED, __HIP_MEMORY_SCOPE_AGENT); }
__device__ __forceinline__ unsigned xb_xcc_id() { return (unsigned)__builtin_amdgcn_s_getreg((3 << 11) | 20) & 0xFu; }
#define XB_SPIN(cond, bar) do { unsigned _sp = 0; while (cond) { __builtin_amdgcn_s_sleep(1); \
    if ((++_sp & 255u) == 0u) { if (xb_ld(&(bar)[XB_TMO])) break; if (_sp > XB_SPIN_CAP) { atomicAdd(&(bar)[XB_TMO], 1u); break; } } } } while (0)

struct XcdBarrier {
    unsigned* bar; unsigned x;
    volatile LAS unsigned* st;
};

__device__ __forceinline__ XcdBarrier xcd_barrier_post(unsigned* bar, volatile LAS unsigned* st) {
    XcdBarrier b; b.bar = bar; b.x = xb_xcc_id(); b.st = st;
    if (threadIdx.x == 0) (void)xb_add(&bar[XB_XCNT(b.x)], 1u);
    return b;
}
__device__ __forceinline__ void xcd_barrier_complete(unsigned* bar, unsigned x, unsigned& nloc, unsigned& nx) {
    const unsigned G = gridDim.x * gridDim.y * gridDim.z;
    unsigned sum, cnt, mine, sp = 0u;
    for (;;) {
        sum = 0u; cnt = 0u; mine = 0u;
#pragma unroll
        for (unsigned j = 0; j < 16; ++j) { const unsigned c = xb_ld(&bar[XB_XCNT(j)]); sum += c; cnt += (c > 0u) ? 1u : 0u; mine = (j == x) ? c : mine; }
        if (sum == G) break;
        __builtin_amdgcn_s_sleep(1);
        if ((++sp & 255u) == 0u) { if (xb_ld(&bar[XB_TMO])) break; if (sp > XB_SPIN_CAP) { atomicAdd(&bar[XB_TMO], 1u); break; } }
    }
    nloc = mine > 0u ? mine : 1u; nx = cnt > 0u ? cnt : 1u;
}

__device__ __forceinline__ void xcd_barrier(const XcdBarrier& b) {
    asm volatile("s_waitcnt vmcnt(0)" ::: "memory");
    __syncthreads();
    if (threadIdx.x == 0) {
        unsigned* bar = b.bar;
        __builtin_amdgcn_s_waitcnt(0);
        unsigned nloc = b.st[0], nx = b.st[1];
        if (nloc == 0u) { xcd_barrier_complete(bar, b.x, nloc, nx); b.st[0] = nloc; b.st[1] = nx; }
        const unsigned old = xb_add(&bar[XB_XSUB(b.x)], 1u);
        const unsigned gen = old / nloc;
        if (old + 1u == (gen + 1u) * nloc) {
            __builtin_amdgcn_fence(__ATOMIC_RELEASE, "agent");
            asm volatile("s_waitcnt vmcnt(0)" ::: "memory");
            const unsigned og = xb_add(&bar[XB_TOP], 1u);
            const unsigned tg = og / nx;
            if (og + 1u == (tg + 1u) * nx) xb_add(&bar[XB_TOPGEN], 1u);
            else XB_SPIN(xb_ld(&bar[XB_TOPGEN]) == tg, bar);
            __builtin_amdgcn_fence(__ATOMIC_ACQUIRE, "agent");
            xb_add(&bar[XB_XGEN(b.x)], 1u);
            asm volatile("s_waitcnt vmcnt(0)" ::: "memory");
        } else {
            XB_SPIN(xb_ld(&bar[XB_XGEN(b.x)]) == gen, bar);
            __builtin_amdgcn_fence(__ATOMIC_ACQUIRE, "agent");
            asm volatile("s_waitcnt vmcnt(0)" ::: "memory");
        }
    }
    __syncthreads();
}

__global__ void __launch_bounds__(NTHREADS, 2) fwd_megakernel(Params p) {
    extern __shared__ __attribute__((aligned(16))) unsigned char lds_raw[];
    LAS unsigned char* lds = (LAS unsigned char*)lds_raw;
    cg::grid_group grid = cg::this_grid();
    if (threadIdx.x < 64) ((LAS unsigned*)(lds + MISC_OFF))[threadIdx.x] = 0u;
    __syncthreads();
    (void)xcd_barrier_post((unsigned*)(p.ws + WS_BAR), (volatile LAS unsigned*)(lds + MISC_OFF));
    if (p.ph_lo == 0) {
        const int tid = threadIdx.x, lane = tid & 63, wave = __builtin_amdgcn_readfirstlane(tid >> 6);
        const int G = gridDim.x, bx = blockIdx.x;
        const int gw = bx * NWAVES + wave, NGW = G * NWAVES;
        const size_t gt = (size_t)bx * NTHREADS + tid, NT = (size_t)G * NTHREADS;
        unsigned char* ws = p.ws;
        float* cos1 = (float*)(ws + WS_TAB); float* sin1 = cos1 + 2048 * 32; float* cos2 = sin1 + 2048 * 32; float* sin2 = cos2 + 2048 * 32;
        bf16_t* X = (bf16_t*)(ws + WS_X);
        if (bx == 0 && tid == 0) { const float** tabw = (const float**)(ws + WS_PTAB);
#pragma unroll
            for (int i = 0; i < 24; ++i) tabw[i] = p.in[i];
            tabw[24] = (const float*)p.out; }
        if (PHM & 0x400) {
            for (size_t idx = gt; idx < 2048 * 32; idx += NT) {
                const int pos = (int)(idx >> 5), i = (int)(idx & 31);
                const float inv1 = exp2f(-(float)(2 * i) * (1.f / 64.f) * 13.287712379549449f);
                const double t1 = (double)pos * (double)inv1 * 0.15915494309189535;
                const float f1 = (float)(t1 - floor(t1));
                cos1[idx] = __builtin_amdgcn_cosf(f1); sin1[idx] = __builtin_amdgcn_sinf(f1);
                const int ii = i & 15, p2 = (i < 16) ? (pos >> 6) : (pos & 63);
                const float inv2 = exp2f(-(float)(2 * ii) * (1.f / 32.f) * 13.287712379549449f);
                const double t2 = (double)p2 * (double)inv2 * 0.15915494309189535;
                const float f2 = (float)(t2 - floor(t2));
                cos2[idx] = __builtin_amdgcn_cosf(f2); sin2[idx] = __builtin_amdgcn_sinf(f2);
            }
            convert_layer(p.in, ws, 0, lds, gw, NGW, wave, lane, gt, NT);
            for (int m = 4 * gw; m < MTOK; m += 4 * NGW) {
                const float* src = (m < MP) ? p.in[I_XP] + (size_t)m * DM : p.in[I_XS] + (size_t)(m - MP) * DM;
                ln_rows4(src, p.in[I_LN0G], p.in[I_LN0B], X + (size_t)m * DM, nullptr, lane);
            }
        }
        if (p.ph_hi > 1) grid.sync();
    }
    for (int gp = (p.ph_lo < 1 ? 1 : p.ph_lo); gp < p.ph_hi; ++gp) {
        unsigned char* ws_ = p.ws; asm volatile("" : "+s"(ws_));
        unsigned char* ws = as_global(ws_);
        int G_ = gridDim.x, bx_ = blockIdx.x; asm volatile("" : "+s"(G_), "+s"(bx_));
        const int G = G_, bx = bx_;
#define PHASE_IDS() int tid_ = threadIdx.x; asm volatile("" : "+v"(tid_)); const int tid = tid_, lane = tid & 63, wave = __builtin_amdgcn_readfirstlane(tid >> 6); \
        const int gw = bx * NWAVES + wave, NGW = G * NWAVES; const size_t gt = (size_t)bx * NTHREADS + tid, NT = (size_t)G * NTHREADS; (void)lane; (void)gw; (void)NGW; (void)gt; (void)NT;
        float* cos1 = (float*)(ws + WS_TAB); float* sin1 = cos1 + 2048 * 32; float* cos2 = sin1 + 2048 * 32; float* sin2 = cos2 + 2048 * 32;
        bf16_t* Wl = (bf16_t*)(ws + WS_W);
        bf16_t* Pb = (bf16_t*)(ws + WS_P);
        float* EG = (float*)(ws + WS_EDGE); float* EC = EG + EDGE_N; float* EV = EC + EDGE_N;
        bf16_t* X = (bf16_t*)(ws + WS_X); bf16_t* Hb = (bf16_t*)(ws + WS_H); bf16_t* Ob = (bf16_t*)(ws + WS_O); bf16_t* Vt = (bf16_t*)(ws + WS_VT);
        bf16_t* U = (bf16_t*)(ws + WS_U); bf16_t* Gb = (bf16_t*)(ws + WS_G);
        const UTab tab{(const float* const*)(ws + WS_PTAB)};
        float* Y = as_global(p.out);

        {
            const int rslot = p.rep_k <= 0 ? 0 : (p.rep_k == 2 ? 1 : p.rep_k - 2);
            const int nphl = p.rep_k >= 0 ? 9 : 8, l = (gp - 1) / nphl, slot = (gp - 1) % nphl, sl2 = (p.rep_k >= 0 && slot > rslot) ? slot - 1 : slot, k = sl2 == 0 ? 0 : (sl2 == 1 ? 2 : sl2 + 2);
            if (k == 0 && (PHM & 1)) {
                pg8::Gemm g{X, Wl + W_IN, MTOK, INW, DM}; pg8::StaticOrder S; S.init(MTOK, INW, G, bx);
                EpiQKV E{Hb, Vt, cos1, sin1, cos2, sin2, tab[I_QN] + l * 64, tab[I_KN] + l * 64, (LAS float*)(lds + XCH_OFF)};
                pg8::gemm_phase<EpiQKV, pg8::StaticOrder, true, true>(lds, g, S, E);
            } else if (k == 1 && (PHM & 2)) {
                PHASE_IDS();
                const int NT1 = (MTOK / 8) * 5;
                const float* qn = tab[I_QN] + l * 64; const float* kn = tab[I_KN] + l * 64;
                for (int t = gw; t < NT1; t += NGW) {
                    const int rb = t / 5, sg = t % 5;
                    const int row = rb * 8 + (lane >> 3), ch = lane & 7, pos = row & (SEQ - 1);
                    bf16_t* rowp = Hb + (size_t)row * INW + 8 * ch;
                    u32x4 w[4];
#pragma unroll
                    for (int i = 0; i < 4; ++i) { const int s = 4 * sg + i;
                        const int col = (s < 8) ? 64 * s : (s < 10) ? 512 + 64 * (s - 8) : (s < 18) ? 768 + 64 * (s - 10) : 1280 + 64 * (s - 18);
                        w[i] = *(const GAS u32x4*)(rowp + col); }
                    const f32x4 c2 = *(const GAS f32x4*)(cos2 + pos * 32 + 4 * ch), s2 = *(const GAS f32x4*)(sin2 + pos * 32 + 4 * ch);
                    const f32x4 c1 = *(const GAS f32x4*)(cos1 + pos * 32 + 4 * ch), s1 = *(const GAS f32x4*)(sin1 + pos * 32 + 4 * ch);
#pragma unroll
                    for (int i = 0; i < 4; ++i) { const int s = 4 * sg + i;
                        const bool ga = s < 10, isq = (s < 8) || (s >= 10 && s < 18);
                        const int col = (s < 8) ? 64 * s : (s < 10) ? 512 + 64 * (s - 8) : (s < 18) ? 768 + 64 * (s - 10) : 1280 + 64 * (s - 18);
                        f32x4 a, b; unpack8(w[i], a, b);
                        if (ga) {
                            float ss = (a[0] * a[0] + a[1] * a[1]) + (a[2] * a[2] + a[3] * a[3]) + (b[0] * b[0] + b[1] * b[1]) + (b[2] * b[2] + b[3] * b[3]);
                            ss += __shfl_xor(ss, 1); ss += __shfl_xor(ss, 2); ss += __shfl_xor(ss, 4);
                            const float rstd = 1.f / sqrtf(ss * (1.f / 64.f) + QK_EPS);
                            const float* gn = (s < 8 ? qn : kn) + 8 * ch;
                            const f32x4 g0 = *(const GAS f32x4*)gn, g1 = *(const GAS f32x4*)(gn + 4);
                            a = a * rstd * g0; b = b * rstd * g1;
                        }
                        const f32x4 c = ga ? c2 : c1, sn = ga ? s2 : s1;
                        f32x4 oa, ob;
                        oa[0] = a[0] * c[0] - a[1] * sn[0]; oa[1] = a[0] * sn[0] + a[1] * c[0];
                        oa[2] = a[2] * c[1] - a[3] * sn[1]; oa[3] = a[2] * sn[1] + a[3] * c[1];
                        ob[0] = b[0] * c[2] - b[1] * sn[2]; ob[1] = b[0] * sn[2] + b[1] * c[2];
                        ob[2] = b[2] * c[3] - b[3] * sn[3]; ob[3] = b[2] * sn[3] + b[3] * c[3];
                        if (isq) { oa = oa * QSCALE; ob = ob * QSCALE; }
                        *(GAS u32x4*)(rowp + col) = pack8(oa, ob);
                    }
                }
                LAS bf16_t* scr = (LAS bf16_t*)(lds + wave * 16384);
                const int NT2 = (MTOK / 64) * 4;
                for (int t = gw; t < NT2; t += NGW) {
                    const int tt = t >> 2, vs = t & 3, grp = vs >> 1, kh = vs & 1;
                    const int b = tt >> 5, s0 = (tt & 31) * 64;
                    const int col = (grp ? 1408 : 640) + 64 * kh;
                    const int ri = lane >> 3, ch = lane & 7;
#pragma unroll
                    for (int st = 0; st < 8; ++st) {
                        const int tok = ri + 8 * st;
                        const u32x4 w = *(const GAS u32x4*)(Hb + (size_t)(tt * 64 + tok) * INW + col + 8 * ch);
                        scr[(8 * ch + 0) * 72 + tok] = (bf16_t)(w.x & 0xffffu); scr[(8 * ch + 1) * 72 + tok] = (bf16_t)(w.x >> 16);
                        scr[(8 * ch + 2) * 72 + tok] = (bf16_t)(w.y & 0xffffu); scr[(8 * ch + 3) * 72 + tok] = (bf16_t)(w.y >> 16);
                        scr[(8 * ch + 4) * 72 + tok] = (bf16_t)(w.z & 0xffffu); scr[(8 * ch + 5) * 72 + tok] = (bf16_t)(w.z >> 16);
                        scr[(8 * ch + 6) * 72 + tok] = (bf16_t)(w.w & 0xffffu); scr[(8 * ch + 7) * 72 + tok] = (bf16_t)(w.w >> 16);
                    }
                    asm volatile("s_waitcnt lgkmcnt(0)" ::: "memory");
                    bf16_t* dst = Vt + ((size_t)((grp * NSEQ + b) * 2 + kh) * 64) * SEQ + s0;
#pragma unroll
                    for (int st = 0; st < 8; ++st) {
                        const int d = ri + 8 * st;
                        const u32x4 w = *(const LAS u32x4*)(scr + d * 72 + 8 * ch);
                        *(GAS u32x4*)(dst + (size_t)d * SEQ + 8 * ch) = w;
                    }
                    asm volatile("s_waitcnt lgkmcnt(0)" ::: "memory");
                }
            } else if (k == 2 && (PHM & 4)) {
                bool nomax;
                { int t_ = threadIdx.x; asm volatile("" : "+v"(t_)); const int ln = t_ & 63;
                  float gq = fabsf(*(const GAS float*)(tab[I_QN] + l * 64 + ln)), gk = fabsf(*(const GAS float*)(tab[I_KN] + l * 64 + ln));
#pragma unroll
                  for (int o_ = 1; o_ < 64; o_ <<= 1) { gq = fmaxf(gq, __shfl_xor(gq, o_)); gk = fmaxf(gk, __shfl_xor(gk, o_)); }
                  const float bound = 8.f * LOG2E * 1.02f * gq * gk;
                  nomax = __builtin_amdgcn_readfirstlane((int)(bound < 40.f)) != 0; }
                for (int i = 0;; ++i) {
                    const int u = i * G + bx; if (u >= 3072) break;
                    const bool win = u >= 1536; const int uu = win ? u - 1536 : u;
                    const int x = uu & 7, y = uu >> 3, qblk = y & 31, b = x + 8 * (y >> 5);
                    if (win) att::attn_unit<true>(lds, Hb, Vt, Ob, b, qblk, tab[I_SINK] + l * 8, tab[I_ONB] + l * 512, false);
                    else att::attn_unit<false>(lds, Hb, Vt, Ob, b, qblk, nullptr, tab[I_ONA] + l * 512, nomax);
                }
            } else if (k == 3 && (PHM & 8)) {
                PHASE_IDS();
                const float* gap = tab[I_ONA] + l * 512 + 8 * lane; const float* gbp = tab[I_ONB] + l * 512 + 8 * lane;
                const f32x4 ga0 = *(const GAS f32x4*)gap, ga1 = *(const GAS f32x4*)(gap + 4), gb0 = *(const GAS f32x4*)gbp, gb1 = *(const GAS f32x4*)(gbp + 4);
                for (int m = 4 * gw; m < MTOK; m += 4 * NGW) {
                    u32x4 wa[4], wb[4];
#pragma unroll
                    for (int r = 0; r < 4; ++r) { const bf16_t* orow = Ob + (size_t)(m + r) * DM; wa[r] = *(const GAS u32x4*)(orow + 8 * lane); wb[r] = *(const GAS u32x4*)(orow + 512 + 8 * lane); }
                    f32x4 a0[4], a1[4], b0[4], b1[4]; float sa[4], sb[4];
#pragma unroll
                    for (int r = 0; r < 4; ++r) { unpack8(wa[r], a0[r], a1[r]); unpack8(wb[r], b0[r], b1[r]);
                        sa[r] = (a0[r][0] * a0[r][0] + a0[r][1] * a0[r][1]) + (a0[r][2] * a0[r][2] + a0[r][3] * a0[r][3]) + (a1[r][0] * a1[r][0] + a1[r][1] * a1[r][1]) + (a1[r][2] * a1[r][2] + a1[r][3] * a1[r][3]);
                        sb[r] = (b0[r][0] * b0[r][0] + b0[r][1] * b0[r][1]) + (b0[r][2] * b0[r][2] + b0[r][3] * b0[r][3]) + (b1[r][0] * b1[r][0] + b1[r][1] * b1[r][1]) + (b1[r][2] * b1[r][2] + b1[r][3] * b1[r][3]); }
#pragma unroll
                    for (int o = 1; o < 64; o <<= 1)
#pragma unroll
                        for (int r = 0; r < 4; ++r) { sa[r] += __shfl_xor(sa[r], o); sb[r] += __shfl_xor(sb[r], o); }
#pragma unroll
                    for (int r = 0; r < 4; ++r) {
                        const float ra = 1.f / sqrtf(sa[r] * (1.f / 512.f) + LN_EPS), rb = 1.f / sqrtf(sb[r] * (1.f / 512.f) + LN_EPS);
                        bf16_t* orow = Ob + (size_t)(m + r) * DM;
                        *(GAS u32x4*)(orow + 8 * lane) = pack8(a0[r] * ra * ga0, a1[r] * ra * ga1); *(GAS u32x4*)(orow + 512 + 8 * lane) = pack8(b0[r] * rb * gb0, b1[r] * rb * gb1);
                    }
                }
            } else if (k == 4 && (PHM & 16)) {
                pg8::Gemm g{Ob, Wl + W_OUT, MTOK, DM, DM}; pg8::StaticOrder S; S.init(MTOK, DM, G, bx);
                EpiRes<false> E{X, nullptr, Y, (bf16_t*)Y, false, l > 0, (const float*)(ws + WS_ST), tab[I_LN2G] + (l > 0 ? l - 1 : 0) * DM, tab[I_LN2B] + (l > 0 ? l - 1 : 0) * DM, (bf16_t*)Y};
                pg8::gemm_phase<EpiRes<false>, pg8::StaticOrder, true, true>(lds, g, S, E);
            } else if (k == 5 && (PHM & 32)) {
                PHASE_IDS();
                { const float* lg = tab[I_LN1G] + l * DM; const float* lb = tab[I_LN1B] + l * DM;
                  for (int m = 4 * gw; m < MTOK; m += 4 * NGW) ln_rows4_bf16((const bf16_t*)Y + (size_t)m * DM, lg, lb, X + (size_t)m * DM, (float*)(ws + WS_ST) + 2 * (size_t)m, lane); }
            } else if (k == 6 && (PHM & 64)) {
                pg8::Gemm g{X, Wl + W_UP, MTOK, 2 * DFF, DM}; pg8::StaticOrder S; S.init(MTOK, 2 * DFF, G, bx);
                EpiUp E{U, EG, EC, EV, tab[I_CW] + (size_t)l * 3 * DFF, tab[I_CB] + (size_t)l * DFF, (LAS float*)(lds + XCH_OFF)};
                pg8::gemm_phase<EpiUp, pg8::StaticOrder, true, true>(lds, g, S, E);
            } else if (k == 7 && (PHM & 128)) {
                PHASE_IDS();
                const float* cw = tab[I_CW] + (size_t)l * 3 * DFF;
                const size_t NF = (size_t)(MTOK / 256) * 2 * (DFF / 4);
                for (size_t i = gt; i < NF; i += NT) {
                    const int c4 = (int)(i % (DFF / 4)), pe = (int)(i / (DFF / 4)), pm = pe >> 1, e = pe & 1, ch = 4 * c4;
                    const int r0 = pm * 256;
                    if (e == 0) {
                        if ((r0 & (SEQ - 1)) == 0) continue;
                        const size_t me = ((size_t)pm * 2 + 0) * DFF + ch, ne = ((size_t)(pm - 1) * 2 + 1) * DFF + ch;
                        const f32x4 c = *(const GAS f32x4*)(EC + me) + *(const GAS f32x4*)(cw + ch) * *(const GAS f32x4*)(EG + ne); const f32x4 v = *(const GAS f32x4*)(EV + me);
                        u32x2 w; w.x = pk2(gelu_tanh(c[0]) * v[0], gelu_tanh(c[1]) * v[1]); w.y = pk2(gelu_tanh(c[2]) * v[2], gelu_tanh(c[3]) * v[3]);
                        *(GAS u32x2*)(U + (size_t)r0 * DFF + ch) = w;
                    } else {
                        if (((r0 + 256) & (SEQ - 1)) == 0) continue;
                        const size_t me = ((size_t)pm * 2 + 1) * DFF + ch, ne = ((size_t)(pm + 1) * 2 + 0) * DFF + ch;
                        const f32x4 c = *(const GAS f32x4*)(EC + me) + *(const GAS f32x4*)(cw + 2 * DFF + ch) * *(const GAS f32x4*)(EG + ne); const f32x4 v = *(const GAS f32x4*)(EV + me);
                        u32x2 w; w.x = pk2(gelu_tanh(c[0]) * v[0], gelu_tanh(c[1]) * v[1]); w.y = pk2(gelu_tanh(c[2]) * v[2], gelu_tanh(c[3]) * v[3]);
                        *(GAS u32x2*)(U + (size_t)(r0 + 255) * DFF + ch) = w;
                    }
                }
                { pg8::Gemm g{X, Wl + W_GATE, MTOK, DM, DM}; pg8::StaticOrder S; S.init(MTOK, DM, G, bx);
                  EpiGate E{Gb, tab[I_BGATE] + (size_t)l * DM};
                  pg8::gemm_phase<EpiGate, pg8::StaticOrder, true, true>(lds, g, S, E); }
                { pg8::Gemm g{Pb, Wl + W_PLE, MTOK, DM, DPLE}; pg8::StaticOrder S; S.init(MTOK, DM, G, bx);
                  EpiPle E{Gb};
                  pg8::gemm_phase<EpiPle, pg8::StaticOrder, true, true>(lds, g, S, E); }
            } else if (k == 8 && (PHM & 256)) {
                pg8::Gemm g{U, Wl + W_DOWN, MTOK, DM, DFF}; pg8::StaticOrder S; S.init(MTOK, DM, G, bx);
                EpiRes<true> E{X, Gb, Y, (bf16_t*)Y, false, true, (const float*)(ws + WS_ST), tab[I_LN1G] + l * DM, tab[I_LN1B] + l * DM, (l == DEPTH - 1) ? X : (bf16_t*)Y};
                pg8::gemm_phase<EpiRes<true>, pg8::StaticOrder, true, true>(lds, g, S, E);
            } else if (PHM & 0x200) {
                PHASE_IDS();
                const bool lastl = (l == DEPTH - 1);
                { const float* lg = tab[I_LN2G] + l * DM; const float* lb = tab[I_LN2B] + l * DM;
                  if (lastl) { for (int m = 4 * gw; m < MTOK; m += 4 * NGW) ln_rows4_bf16(X + (size_t)m * DM, lg, lb, nullptr, nullptr, lane, Y + (size_t)m * DM); }
                  else { for (int m = 4 * gw; m < MTOK; m += 4 * NGW) ln_rows4_bf16((const bf16_t*)Y + (size_t)m * DM, lg, lb, X + (size_t)m * DM, (float*)(ws + WS_ST) + 2 * (size_t)m, lane); } }
                if (!lastl) convert_layer(tab, ws, l + 1, lds, gw, NGW, wave, lane, gt, NT);
            }
        }
        if (gp + 1 < p.ph_hi) { XcdBarrier xb; xb.bar = (unsigned*)(ws + WS_BAR); xb.x = xb_xcc_id(); xb.st = (volatile LAS unsigned*)(lds + MISC_OFF); xcd_barrier(xb); }
    }
}

extern "C" void kernel_launch(void* const* d_in, const int* in_sizes, int n_in, void* d_out, int out_size, void* d_ws, size_t ws_size, hipStream_t stream) {
    static int grid = 0;
    if (grid == 0) {
        if (n_in != 24 || out_size != MTOK * DM || ws_size < WS_NEED) { fprintf(stderr, "kernel_launch: unexpected shapes (n_in %d, out %d, ws %zu, need %zu)\n", n_in, out_size, ws_size, (size_t)WS_NEED); grid = -1; return; }
        int dev = 0, cus = 0, per_cu = 0;
        hipGetDevice(&dev);
        hipDeviceGetAttribute(&cus, hipDeviceAttributeMultiprocessorCount, dev);
        if (hipFuncSetAttribute((const void*)fwd_megakernel, hipFuncAttributeMaxDynamicSharedMemorySize, LDS_BYTES) != hipSuccess) { fprintf(stderr, "kernel_launch: hipFuncSetAttribute failed\n"); grid = -1; return; }
        if (hipOccupancyMaxActiveBlocksPerMultiprocessor(&per_cu, (const void*)fwd_megakernel, NTHREADS, LDS_BYTES) != hipSuccess || per_cu < 1) { fprintf(stderr, "kernel_launch: occupancy query says %d\n", per_cu); (void)hipGetLastError(); per_cu = 1; }
        grid = cus * per_cu;
        fprintf(stderr, "kernel_launch: grid %d (cus %d x %d)\n", grid, cus, per_cu);
    }
    if (grid < 0) return;
    if (hipMemsetAsync((char*)d_ws + WS_BAR, 0, 16384, stream) != hipSuccess) { fprintf(stderr, "kernel_launch: memset failed\n"); return; }
    Params p{};
    for (int i = 0; i < 24; ++i) p.in[i] = (const float*)d_in[i];
    p.out = (float*)d_out; p.ws = (unsigned char*)d_ws;
#if MK_PER_PHASE_LAUNCH
    for (int ph = 0; ph < NPHASES; ++ph) {
        p.ph_lo = ph; p.ph_hi = ph + 1;
        void* args[] = {&p};
        hipError_t e = hipLaunchCooperativeKernel((const void*)fwd_megakernel, dim3(grid), dim3(NTHREADS), args, LDS_BYTES, stream);
        if (e != hipSuccess) { fprintf(stderr, "launch %d failed: %s\n", ph, hipGetErrorString(e)); break; }
    }
#else
    p.rep_k = REP_K; p.ph_lo = 0; p.ph_hi = 1 + (REP_K >= 0 ? 9 : 8) * DEPTH;
    void* args[] = {&p};
    hipError_t e = hipLaunchCooperativeKernel((const void*)fwd_megakernel, dim3(grid), dim3(NTHREADS), args, LDS_BYTES, stream);
    if (e != hipSuccess) fprintf(stderr, "cooperative launch failed: %s (grid %d)\n", hipGetErrorString(e), grid);
#endif
}
```
